# Optimizing an MI355X kernel written in HIP

```python
import math
import jax, jax.numpy as jnp
from jax import lax
import numpy as np

D_MODEL = 1024
BATCH = 32
SEQ = 256
DEPTH = 4
DEC_BATCH = 4
DEC_SEQ = 2048
PAST_LEN = 256

GRID_W = 64
N_MIXERS = 2
N_FOURIER_LAYERS = (DEPTH + 1) // 2
N_ATTN_LAYERS = DEPTH // 2
N_HEADS = 8
HEAD_DIM = 64
V_DIM = 2 * HEAD_DIM
N_FOURIER_GROUPS = 4
FOURIER_GROUP = D_MODEL // N_FOURIER_GROUPS
D_FF = 2816
CONV_WIDTH = 3
ROPE_THETA = 10000.0
AXIS_DIM = HEAD_DIM // 2
N_FREQ = AXIS_DIM // 2
Q_BLOCK = 128
DN_ALPHA = (2 * DEPTH) ** 0.25
DN_BETA = (8 * DEPTH) ** -0.25
LN_EPS = 1e-6
SUBLN_EPS = 1e-5

kernel_name = "hybrid_fourier_diffattn_dit_step"


def _ln_f32(x):
    x32 = x.astype(jnp.float32)
    mu = jnp.mean(x32, axis=-1, keepdims=True)
    var = jnp.mean(jnp.square(x32 - mu), axis=-1, keepdims=True)
    return (x32 - mu) * lax.rsqrt(var + LN_EPS)


def modulate(x, shift, scale):
    return (_ln_f32(x) * (1.0 + scale.astype(jnp.float32)) + shift.astype(jnp.float32)).astype(x.dtype)


def post_norm(x, update, g, b):
    z = DN_ALPHA * x.astype(jnp.float32) + update.astype(jnp.float32)
    y = _ln_f32(z) * g.astype(jnp.float32) + b.astype(jnp.float32)
    return y.astype(x.dtype)


def ada_params(cvec, w, b):
    a = jax.nn.silu(cvec) @ w + b
    return jnp.split(a[:, None, :], 6, axis=-1)


def fourier_mix(h, w_f):
    bn, n, d = h.shape
    hg = h.astype(jnp.float32).reshape(bn, n, N_FOURIER_GROUPS, FOURIER_GROUP)
    f = jnp.fft.fft2(hg, axes=(1, 3), norm="ortho").real
    return f.reshape(bn, n, d).astype(h.dtype) @ w_f


def conv_ffn(h, w_up, conv_w, conv_b, w_down):
    n = h.shape[1]
    u = h @ w_up
    up = jnp.pad(u, ((0, 0), (1, 1), (0, 0)))
    u = up[:, 0:n] * conv_w[0] + up[:, 1:n + 1] * conv_w[1] + up[:, 2:n + 2] * conv_w[2] + conv_b
    a, g = jnp.split(u, 2, axis=-1)
    return (jax.nn.silu(a) * g) @ w_down


def axial_rope_tables(n, dtype):
    rows = n // GRID_W
    row = jnp.repeat(jnp.arange(rows), GRID_W).astype(jnp.float32)
    col = jnp.tile(jnp.arange(GRID_W), rows).astype(jnp.float32)
    inv = 1.0 / (ROPE_THETA ** (jnp.arange(N_FREQ, dtype=jnp.float32) / N_FREQ))
    ar = row[:, None] * inv
    ac = col[:, None] * inv
    ang = jnp.concatenate([ar, ar, ac, ac], axis=-1)
    return jnp.cos(ang).astype(dtype), jnp.sin(ang).astype(dtype)


def rotate_half_axial(x):
    xs = x.reshape(x.shape[:-1] + (2, 2, N_FREQ))
    xs = jnp.concatenate([-xs[..., 1:, :], xs[..., :1, :]], axis=-2)
    return xs.reshape(x.shape)


def apply_rope(x, cos, sin):
    c = cos[None, :, None, None, :]
    s = sin[None, :, None, None, :]
    return x * c + rotate_half_axial(x) * s


def qkv_proj(h, w):
    bn, n, _ = h.shape
    q, k, v = jnp.split(h @ w, 3, axis=-1)
    return (q.reshape(bn, n, N_HEADS, 2, HEAD_DIM),
            k.reshape(bn, n, N_HEADS, 2, HEAD_DIM),
            v.reshape(bn, n, N_HEADS, V_DIM))


def diff_lambda(lq1, lk1, lq2, lk2, lam_init):
    f = jnp.float32
    return (jnp.exp(jnp.sum(lq1.astype(f) * lk1.astype(f)))
            - jnp.exp(jnp.sum(lq2.astype(f) * lk2.astype(f))) + lam_init)


def diff_attention(q, k, v, lam):
    bn, nq = q.shape[0], q.shape[1]
    nblk = nq // Q_BLOCK
    qb = jnp.moveaxis(q.reshape(bn, nblk, Q_BLOCK, N_HEADS, 2, HEAD_DIM), 1, 0)
    scale = HEAD_DIM ** -0.5

    def one_block(qblk):
        s = jnp.einsum('bqhtd,bkhtd->bhtqk', qblk, k).astype(jnp.float32) * scale
        p = jax.nn.softmax(s, axis=-1)
        w = p[:, :, 0] - lam * p[:, :, 1]
        return jnp.einsum('bhqk,bkhe->bqhe', w.astype(v.dtype), v)

    out = lax.map(one_block, qb)
    return jnp.moveaxis(out, 0, 1).reshape(bn, nq, N_HEADS, V_DIM)


def diff_attn_output(o, g, lam_init, w_o):
    bn, n = o.shape[0], o.shape[1]
    o32 = o.astype(jnp.float32)
    o32 = o32 * lax.rsqrt(jnp.mean(jnp.square(o32), axis=-1, keepdims=True) + SUBLN_EPS)
    o32 = o32 * g.astype(jnp.float32) * (1.0 - lam_init)
    return o32.reshape(bn, n, D_MODEL).astype(o.dtype) @ w_o


def setup_inputs(seed: int = 0) -> dict:
    key = jax.random.key(seed)
    ks = jax.random.split(key, 24)
    nrm = jax.random.normal
    f = jnp.float32
    d = D_MODEL
    v_col_scale = jnp.concatenate([jnp.ones((2 * d,), f), jnp.full((d,), DN_BETA, f)])
    return {
        "x_prompt": nrm(ks[0], (BATCH, SEQ, d), f),
        "x_sample": nrm(ks[1], (DEC_BATCH, DEC_SEQ, d), f),
        "cache_k": nrm(ks[2], (DEC_BATCH, N_ATTN_LAYERS, PAST_LEN, N_HEADS, 2, HEAD_DIM), f),
        "cache_v": nrm(ks[3], (DEC_BATCH, N_ATTN_LAYERS, PAST_LEN, N_HEADS, V_DIM), f) * DN_BETA,
        "c": nrm(ks[4], (DEC_BATCH, d), f),
        "c_ctx": nrm(ks[5], (d,), f),
        "w_ada": nrm(ks[6], (DEPTH, d, 6 * d), f) * d ** -0.5,
        "b_ada": nrm(ks[7], (DEPTH, 6 * d), f) * 0.02,
        "w_fourier": nrm(ks[8], (N_FOURIER_LAYERS, d, d), f) * (d ** -0.5 * DN_BETA),
        "w_qkv": nrm(ks[9], (N_ATTN_LAYERS, d, 3 * d), f) * d ** -0.5 * v_col_scale,
        "lambda_q1": nrm(ks[10], (N_ATTN_LAYERS, HEAD_DIM), f) * 0.1,
        "lambda_k1": nrm(ks[11], (N_ATTN_LAYERS, HEAD_DIM), f) * 0.1,
        "lambda_q2": nrm(ks[12], (N_ATTN_LAYERS, HEAD_DIM), f) * 0.1,
        "lambda_k2": nrm(ks[13], (N_ATTN_LAYERS, HEAD_DIM), f) * 0.1,
        "subln_g": 1.0 + 0.02 * nrm(ks[14], (N_ATTN_LAYERS, V_DIM), f),
        "w_o": nrm(ks[15], (N_ATTN_LAYERS, d, d), f) * (d ** -0.5 * DN_BETA),
        "w_up": nrm(ks[16], (DEPTH, d, 2 * D_FF), f) * (d ** -0.5 * DN_BETA),
        "conv_w": nrm(ks[17], (DEPTH, CONV_WIDTH, 2 * D_FF), f) * CONV_WIDTH ** -0.5,
        "conv_b": nrm(ks[18], (DEPTH, 2 * D_FF), f) * 0.02,
        "w_down": nrm(ks[19], (DEPTH, D_FF, d), f) * (D_FF ** -0.5 * DN_BETA),
        "ln1_g": 1.0 + 0.02 * nrm(ks[20], (DEPTH, d), f),
        "ln1_b": 0.02 * nrm(ks[21], (DEPTH, d), f),
        "ln2_g": 1.0 + 0.02 * nrm(ks[22], (DEPTH, d), f),
        "ln2_b": 0.02 * nrm(ks[23], (DEPTH, d), f),
    }


def reference(x_prompt, x_sample, cache_k, cache_v, c, c_ctx, w_ada, b_ada, w_fourier, w_qkv,
              lambda_q1, lambda_k1, lambda_q2, lambda_k2, subln_g, w_o, w_up, conv_w, conv_b,
              w_down, ln1_g, ln1_b, ln2_g, ln2_b):
    n_lat = x_sample.shape[1]
    cos, sin = axial_rope_tables(n_lat, x_sample.dtype)
    c_ctx_row = c_ctx[None, :]
    xc, xl = x_prompt, x_sample
    new_k, new_v = [], []
    for i in range(DEPTH):
        j = i // N_MIXERS
        sh1c, sc1c, g1c, sh2c, sc2c, g2c = ada_params(c_ctx_row, w_ada[i], b_ada[i])
        sh1l, sc1l, g1l, sh2l, sc2l, g2l = ada_params(c, w_ada[i], b_ada[i])
        hc = modulate(xc, sh1c, sc1c)
        hl = modulate(xl, sh1l, sc1l)
        if i % N_MIXERS == 0:
            mc = fourier_mix(hc, w_fourier[j])
            ml = fourier_mix(hl, w_fourier[j])
        else:
            lam_init = 0.8 - 0.6 * math.exp(-0.3 * i)
            lam = diff_lambda(lambda_q1[j], lambda_k1[j], lambda_q2[j], lambda_k2[j], lam_init)
            qc, kc, vc = qkv_proj(hc, w_qkv[j])
            oc = diff_attention(qc, kc, vc, lam)
            mc = diff_attn_output(oc, subln_g[j], lam_init, w_o[j])
            new_k.append(kc)
            new_v.append(vc)
            ql, kl, vl = qkv_proj(hl, w_qkv[j])
            ql = apply_rope(ql, cos, sin)
            kl = apply_rope(kl, cos, sin)
            k_all = jnp.concatenate([kl, cache_k[:, j]], axis=1)
            v_all = jnp.concatenate([vl, cache_v[:, j]], axis=1)
            ol = diff_attention(ql, k_all, v_all, lam)
            ml = diff_attn_output(ol, subln_g[j], lam_init, w_o[j])
        xc = post_norm(xc, g1c * mc, ln1_g[i], ln1_b[i])
        xl = post_norm(xl, g1l * ml, ln1_g[i], ln1_b[i])
        fc = conv_ffn(modulate(xc, sh2c, sc2c), w_up[i], conv_w[i], conv_b[i], w_down[i])
        fl = conv_ffn(modulate(xl, sh2l, sc2l), w_up[i], conv_w[i], conv_b[i], w_down[i])
        xc = post_norm(xc, g2c * fc, ln2_g[i], ln2_b[i])
        xl = post_norm(xl, g2l * fl, ln2_g[i], ln2_b[i])
    new_cache_k = jnp.stack(new_k, axis=1)
    new_cache_v = jnp.stack(new_v, axis=1)
    return (xc, xl, new_cache_k, new_cache_v)
```

```cpp
#include <hip/hip_runtime.h>
#include <cstdio>
#include <cstdint>

#ifndef MK_PER_STEP_LAUNCH
#define MK_PER_STEP_LAUNCH 0
#endif

#define LAS __attribute__((address_space(3)))
#define GAS __attribute__((address_space(1)))
typedef _Float16 h16;
typedef _Float16 h16x8 __attribute__((ext_vector_type(8)));
typedef _Float16 h16x4 __attribute__((ext_vector_type(4)));
typedef _Float16 h16x2 __attribute__((ext_vector_type(2)));
typedef float f32x2 __attribute__((ext_vector_type(2)));
typedef float f32x4 __attribute__((ext_vector_type(4)));
typedef float f32x8 __attribute__((ext_vector_type(8)));
typedef float f32x16 __attribute__((ext_vector_type(16)));
typedef unsigned u32x2 __attribute__((ext_vector_type(2)));
typedef unsigned u32x4 __attribute__((ext_vector_type(4)));
typedef short s16x4 __attribute__((ext_vector_type(4)));

__device__ __forceinline__ unsigned pkh(float lo, float hi) { f32x2 v = {lo, hi}; h16x2 h = __builtin_convertvector(v, h16x2); return __builtin_bit_cast(unsigned, h); }

constexpr int DM = 1024, NTOK = 16384, NCTX = 8192, SEQC = 256, SEQL = 2048, NBL = 4, NBC = 32, PAST = 256, KVL = SEQL + PAST;
constexpr int DEPTH = 4, NH = 8, DFF = 2816, DFF2 = 5632;
constexpr int KROWS = NCTX + NBL * KVL;
constexpr float DN_ALPHA = 1.681792830507429f;
constexpr float LN_EPS = 1e-6f, SUBLN_EPS = 1e-5f;

constexpr size_t MiB = 1u << 20;
constexpr size_t WS_CTL = 0, CTL_ZERO_BYTES = 64 * 1024;
constexpr size_t WS_ADA = 1 * MiB;
constexpr size_t WS_ROPE = 1 * MiB + 512 * 1024;
constexpr size_t WS_HALO = 2 * MiB;
constexpr size_t WS_D256 = 4 * MiB;
constexpr size_t WS_D2048 = 5 * MiB;
constexpr size_t WS_WFT = 21 * MiB;
constexpr size_t WS_WPT = 25 * MiB;
constexpr size_t WS_WQKV = 33 * MiB;
constexpr size_t WS_WO = 39 * MiB;
constexpr size_t WS_WUP = 41 * MiB;
constexpr size_t WS_WDN = 52 * MiB;
constexpr size_t WS_H = 58 * MiB;
constexpr size_t WS_U0 = 90 * MiB;
constexpr size_t WS_U1 = 122 * MiB;
constexpr size_t WS_ARENA = 154 * MiB;
constexpr size_t WS_Q = WS_ARENA, WS_K = WS_ARENA + 32 * MiB, WS_V = WS_ARENA + 66 * MiB, WS_O = WS_ARENA + 100 * MiB;
constexpr size_t WS_END = 330 * MiB;
static_assert((size_t)KROWS * DM * 2 <= 34 * MiB, "K/V buffers");

constexpr int CW_BAR = 1024;

constexpr int RING_BYTES = 131072;
constexpr int LDSCTL_OFF = RING_BYTES, MISC_OFF = LDSCTL_OFF + 320;
constexpr int LDS_BYTES = 147456;

namespace pg8 {
constexpr int BM = 256, BK = 64, HALF = 128, HTB = HALF * BK * 2, STAGE_BYTES = 8 * HTB, NXCD = 8, WGM = 8;
__host__ __device__ __forceinline__ int lds_byte(int r, int c) { const int st = (r >> 4) * 2 + (c >> 5), rr = r & 15, cc = c & 31, ob = rr * 64 + cc * 2; return st * 1024 + (ob ^ (((ob >> 9) & 1) << 5)); }
__host__ __device__ __forceinline__ void stage_rc(int b, int& R, int& C) { const int st = b / 1024, sb = b % 1024, swz = sb ^ (((sb >> 9) & 1) << 5); R = (st >> 1) * 16 + swz / 64; C = (st & 1) * 32 + (swz % 64) / 2; }
__host__ __device__ __forceinline__ int perm32(int rho) { const int n = rho >> 4, i = rho & 15; return 8 * (i >> 2) + 4 * n + (i & 3); }

struct Unit { const char* a; const char* b; h16* o; int pm, pn; };

struct GSched {
    int nM, nN, nwg, total, G, c;
    int n0, n1;
    long as[3], bs[3], os[3];
    const char* A; const char* B; h16* O; long lda, ldb, ldc;
    __device__ __forceinline__ bool next(int i, Unit& u) const {
        const long L = (long)i * G + c; if (L >= total) return false;
        const int batch = (int)(L / nwg); int wgid = (int)(L % nwg);
        { const int q = nwg / NXCD, r = nwg % NXCD, xcd = wgid % NXCD, off = wgid / NXCD; wgid = (xcd < r ? xcd * (q + 1) : r * (q + 1) + (xcd - r) * q) + off; }
        const int nig = WGM * nN, gid = wgid / nig, fm = gid * WGM, gsz = (nM - fm) < WGM ? (nM - fm) : WGM;
        const int pm = fm + ((wgid % nig) % gsz), pn = (wgid % nig) / gsz;
        const int b0 = batch % n0, b1 = (batch / n0) % n1, b2 = batch / (n0 * n1);
        u.a = A + b0 * as[0] + b1 * as[1] + b2 * as[2] + (long)pm * BM * lda * 2;
        u.b = B + b0 * bs[0] + b1 * bs[1] + b2 * bs[2] + (long)pn * BM * ldb * 2;
        u.o = O + b0 * os[0] + b1 * os[1] + b2 * os[2] + (long)pm * BM * ldc + (long)pn * BM;
        u.pm = pm; u.pn = pn; return true;
    }
};

struct EpiStore16 {
    static constexpr bool PERM = true;
    long ldc; h16* halo;
    __device__ __forceinline__ void operator()(const f32x4 (&acc)[2][2][4][2], const Unit& u, int wr, int wc, int fr, int fq) const {
        asm volatile("" : "+v"(fr), "+v"(fq));
        const int col0 = wc * 32 + 8 * fq;
#pragma unroll
        for (int ai = 0; ai < 2; ++ai)
#pragma unroll
            for (int m = 0; m < 4; ++m) { const int r = ai * HALF + wr * 64 + m * 16 + fr; h16* rowp = u.o + (size_t)r * ldc + col0;
#pragma unroll
                for (int bj = 0; bj < 2; ++bj) { const f32x4 v0 = acc[ai][bj][m][0], v1 = acc[ai][bj][m][1];
                    u32x4 w; w.x = pkh(v0[0], v0[1]); w.y = pkh(v0[2], v0[3]); w.z = pkh(v1[0], v1[1]); w.w = pkh(v1[2], v1[3]);
                    *(u32x4*)(rowp + bj * HALF) = w;
                    if (halo && (r == 0 || r == 255)) *(u32x4*)(halo + ((size_t)u.pm * 2 + (r ? 1 : 0)) * ldc + (size_t)u.pn * BM + col0 + bj * HALF) = w; } }
    }
};

struct EpiQKV {
    static constexpr bool PERM = false;
    h16 *Q, *K, *V; float* nck; float* ncv; const float* rope; int j;
    __device__ __forceinline__ void operator()(const f32x4 (&acc)[2][2][4][2], const Unit& u, int wr, int wc, int fr, int fq) const {
        asm volatile("" : "+v"(fr), "+v"(fq));
        const int sect = u.pn >> 2, pnl = u.pn & 3; const bool lat = u.pm >= 32;
        const int bl = lat ? (u.pm - 32) >> 3 : 0, pml = lat ? (u.pm - 32) & 7 : 0;
        const long qrow0 = (long)u.pm * 256, krow0 = lat ? (long)NCTX + (long)bl * KVL + pml * 256 : (long)u.pm * 256;
        h16* dst = sect == 0 ? Q + qrow0 * DM : (sect == 1 ? K + krow0 * DM : V + krow0 * DM);
        const int colb = pnl * 256 + wc * 32 + 4 * fq;
        if (lat && sect < 2) {
            const int axis = wc & 1;
#pragma unroll
            for (int ai = 0; ai < 2; ++ai)
#pragma unroll
                for (int m = 0; m < 4; ++m) { const int r = ai * HALF + wr * 64 + m * 16 + fr;
                    const int pos = axis ? (m * 16 + fr) : (pml * 4 + ai * 2 + wr);
                    const f32x4 cs = *(const f32x4*)(rope + pos * 16 + 4 * fq), sn = *(const f32x4*)(rope + 1024 + pos * 16 + 4 * fq);
#pragma unroll
                    for (int bj = 0; bj < 2; ++bj) { const f32x4 x0 = acc[ai][bj][m][0], x1 = acc[ai][bj][m][1];
                        const f32x4 y0 = x0 * cs - x1 * sn, y1 = x1 * cs + x0 * sn;
                        h16* p = dst + (size_t)r * DM + colb + bj * HALF;
                        u32x2 w0, w1; w0.x = pkh(y0[0], y0[1]); w0.y = pkh(y0[2], y0[3]); w1.x = pkh(y1[0], y1[1]); w1.y = pkh(y1[2], y1[3]);
                        *(u32x2*)p = w0; *(u32x2*)(p + 16) = w1; }
                    asm volatile("" ::: "memory"); }
        } else {
            float* nc = (sect == 0 || lat) ? nullptr : (sect == 1 ? nck : ncv) + ((size_t)(u.pm * 2 + j) * 256) * DM;
#pragma unroll
            for (int ai = 0; ai < 2; ++ai)
#pragma unroll
                for (int m = 0; m < 4; ++m) { const int r = ai * HALF + wr * 64 + m * 16 + fr;
#pragma unroll
                    for (int bj = 0; bj < 2; ++bj) { const f32x4 y0 = acc[ai][bj][m][0], y1 = acc[ai][bj][m][1];
                        h16* p = dst + (size_t)r * DM + colb + bj * HALF;
                        u32x2 w0, w1; w0.x = pkh(y0[0], y0[1]); w0.y = pkh(y0[2], y0[3]); w1.x = pkh(y1[0], y1[1]); w1.y = pkh(y1[2], y1[3]);
                        *(u32x2*)p = w0; *(u32x2*)(p + 16) = w1;
                        if (nc) { float* q = nc + (size_t)r * DM + colb + bj * HALF; *(f32x4*)q = y0; *(f32x4*)(q + 16) = y1; } }
                    asm volatile("" ::: "memory"); }
        }
    }
};

template <class Epi, class Sched>
__device__ __forceinline__ void gemm_phase(LAS unsigned char* lds, const int tid, const int K, const long lda, const long ldb, const Sched& S, const Epi& E) {
    const int wid = __builtin_amdgcn_readfirstlane(tid >> 6), lane = tid & 63, wr = wid >> 2, wc = wid & 3, fr = lane & 15, fq = lane >> 4;
    const int nt = K / BK;
    unsigned voffA[2], voffB[2];
#pragma unroll
    for (int i = 0; i < 2; ++i) { int R, C; stage_rc(tid * 16 + i * 8192, R, C); const int Rb = Epi::PERM ? ((R & ~31) + perm32(R & 31)) : R;
        voffA[i] = (unsigned)((long)R * lda + C) * 2u; voffB[i] = (unsigned)((long)Rb * ldb + C) * 2u; }
    const size_t kstep = (size_t)(BK * 2);
    const size_t hstepA = (size_t)HALF * lda * 2, hstepB = (size_t)HALF * ldb * 2;
    const unsigned ldsw = (unsigned)wid * 1024u;
    const int aoff = lds_byte(wr * 64 + fr, fq * 8), boff = lds_byte(wc * 32 + fr, fq * 8);
#define PG8_SA(b, h) (((b) * 2 + (h)) * HTB)
#define PG8_SB(b, h) ((4 + (b) * 2 + (h)) * HTB)
#define PG8_STAGE(bufoff, gbase, voff) do { _Pragma("unroll") for (int _i = 0; _i < 2; ++_i) \
        __builtin_amdgcn_global_load_lds((const unsigned*)((const char*)(gbase) + (voff)[_i]), (LAS unsigned*)(lds + (bufoff) + ldsw + _i * 8192), 16, 0, 0); } while (0)
#define PG8_LDA(dst, b, h) do { _Pragma("unroll") for (int m = 0; m < 4; ++m) _Pragma("unroll") for (int k = 0; k < 2; ++k) dst[m][k] = *(const LAS h16x8*)(lds + PG8_SA(b, h) + aoff + m * 2048 + k * 1024); } while (0)
#define PG8_LDB(dst, b, h) do { _Pragma("unroll") for (int n = 0; n < 2; ++n) _Pragma("unroll") for (int k = 0; k < 2; ++k) dst[n][k] = *(const LAS h16x8*)(lds + PG8_SB(b, h) + boff + n * 2048 + k * 1024); } while (0)
#define PG8_MMA(ai, bj, At, Bt) do { __builtin_amdgcn_s_setprio(1); _Pragma("unroll") for (int m = 0; m < 4; ++m) _Pragma("unroll") for (int n = 0; n < 2; ++n) _Pragma("unroll") for (int k = 0; k < 2; ++k) \
        acc[ai][bj][m][n] = __builtin_amdgcn_mfma_f32_16x16x32_f16(Bt[n][k], At[m][k], acc[ai][bj][m][n], 0, 0, 0); __builtin_amdgcn_s_setprio(0); } while (0)
#define PG8_WAIT_V(n) asm volatile("s_waitcnt vmcnt(" #n ")" ::: "memory")
#define PG8_WAIT_L(n) asm volatile("s_waitcnt lgkmcnt(" #n ")" ::: "memory")
#define PG8_BAR __builtin_amdgcn_s_barrier()
#define PG8_SCHED __builtin_amdgcn_sched_barrier(0)
    Unit cur, nxt; int ui = 0;
    if (!S.next(0, cur)) return;
    f32x4 acc[2][2][4][2];
#pragma unroll
    for (int a = 0; a < 2; ++a)
#pragma unroll
        for (int b = 0; b < 2; ++b)
#pragma unroll
            for (int m = 0; m < 4; ++m)
#pragma unroll
                for (int n = 0; n < 2; ++n) acc[a][b][m][n] = (f32x4){0.f, 0.f, 0.f, 0.f};
    h16x8 At[4][2], B0[2][2], B1[2][2];
    const char* cA = cur.a; const char* cB = cur.b;
    PG8_STAGE(PG8_SB(0, 0), cB, voffB); PG8_STAGE(PG8_SB(0, 1), cB + hstepB, voffB); PG8_STAGE(PG8_SA(0, 0), cA, voffA); PG8_STAGE(PG8_SA(0, 1), cA + hstepA, voffA);
    if (wr == 1) PG8_BAR;
    PG8_WAIT_V(2); PG8_BAR;
    PG8_STAGE(PG8_SB(1, 0), cB + kstep, voffB); PG8_STAGE(PG8_SA(1, 0), cA + kstep, voffA); PG8_STAGE(PG8_SB(1, 1), cB + hstepB + kstep, voffB);
    PG8_WAIT_V(6); PG8_BAR;
    for (;;) {
        const bool has_next = S.next(ui + 1, nxt);
        const char* nA = has_next ? nxt.a : cA; const char* nB = has_next ? nxt.b : cB;
        for (int t = 0; t < nt; t += 2) {
            const bool last = (t == nt - 2);
            const char* a1 = cA + (size_t)(t + 1) * kstep;
            const char* a2 = last ? nA : cA + (size_t)(t + 2) * kstep; const char* b2 = last ? nB : cB + (size_t)(t + 2) * kstep;
            const char* a3 = a2 + kstep; const char* b3 = b2 + kstep;
            PG8_LDB(B0, 0, 0); PG8_LDB(B1, 0, 1); PG8_SCHED; PG8_LDA(At, 0, 0); PG8_STAGE(PG8_SA(1, 1), a1 + hstepA, voffA);
            PG8_WAIT_V(8); PG8_WAIT_L(0); PG8_BAR; PG8_MMA(0, 0, At, B0); PG8_MMA(0, 1, At, B1); PG8_BAR; PG8_SCHED;
            PG8_LDA(At, 0, 1); PG8_STAGE(PG8_SB(0, 0), b2, voffB); PG8_STAGE(PG8_SB(0, 1), b2 + hstepB, voffB); PG8_STAGE(PG8_SA(0, 0), a2, voffA);
            PG8_WAIT_V(8); PG8_WAIT_L(0); PG8_BAR; PG8_MMA(1, 0, At, B0); PG8_MMA(1, 1, At, B1); PG8_BAR; PG8_SCHED;
            PG8_LDB(B0, 1, 0); PG8_LDB(B1, 1, 1); PG8_SCHED; PG8_LDA(At, 1, 0); PG8_STAGE(PG8_SA(0, 1), a2 + hstepA, voffA);
            PG8_WAIT_V(8); PG8_WAIT_L(0); PG8_BAR; PG8_MMA(0, 0, At, B0); PG8_MMA(0, 1, At, B1); PG8_BAR; PG8_SCHED;
            PG8_LDA(At, 1, 1); PG8_STAGE(PG8_SB(1, 0), b3, voffB); PG8_STAGE(PG8_SB(1, 1), b3 + hstepB, voffB); PG8_STAGE(PG8_SA(1, 0), a3, voffA);
            PG8_WAIT_V(8); PG8_WAIT_L(0); PG8_BAR; PG8_MMA(1, 0, At, B0); PG8_MMA(1, 1, At, B1); PG8_BAR; PG8_SCHED;
        }
        if (wr == 0) PG8_BAR;
        E(acc, cur, wr, wc, fr, fq);
        if (!has_next) break;
#pragma unroll
        for (int a = 0; a < 2; ++a)
#pragma unroll
            for (int b = 0; b < 2; ++b)
#pragma unroll
                for (int m = 0; m < 4; ++m)
#pragma unroll
                    for (int n = 0; n < 2; ++n) acc[a][b][m][n] = (f32x4){0.f, 0.f, 0.f, 0.f};
        cur = nxt; cA = nA; cB = nB; ++ui;
        if (wr == 1) PG8_BAR;
    }
    PG8_WAIT_V(0);
    PG8_BAR;
#undef PG8_SA
#undef PG8_SB
#undef PG8_STAGE
#undef PG8_LDA
#undef PG8_LDB
#undef PG8_MMA
#undef PG8_WAIT_V
#undef PG8_WAIT_L
#undef PG8_BAR
#undef PG8_SCHED
}
}

namespace attn {
constexpr int D = 128, KVBLK = 64, QBLK = 32;
constexpr float SCALE = 0.125f;
constexpr float THR = 8.f;
constexpr size_t SHM_V = KVBLK * D * 2, SHM_K = KVBLK * D * 2, SHM_ATTN = 2 * SHM_V + 2 * SHM_K + 8 * 64 * 4;
#define KSWZ(row, colB) ((row) * 256 + ((colB) ^ (((row) & 7) << 4)))
#define SBAR() __builtin_amdgcn_sched_barrier(0)
__device__ __forceinline__ int crow(int r, int hi) { return (r & 3) + 8 * (r >> 2) + 4 * hi; }
__device__ __forceinline__ void partialSM(f32x16& p0, f32x16& p1, float& m_reg, float& mn, float& alpha) {
  constexpr float C = SCALE * 1.4426950408889634f;
  float pmax = p0[0];
#pragma unroll
  for (int r = 1; r < 16; ++r) pmax = fmaxf(pmax, p0[r]);
#pragma unroll
  for (int r = 0; r < 16; ++r) pmax = fmaxf(pmax, p1[r]);
  { auto rr = __builtin_amdgcn_permlane32_swap(__float_as_uint(pmax), __float_as_uint(pmax), false, false);
    pmax = fmaxf(__uint_as_float(rr[0]), __uint_as_float(rr[1])); }
  if (__builtin_expect(__all(pmax - m_reg <= THR / SCALE), 1)) { mn = m_reg; alpha = 1.f; }
  else { mn = fmaxf(m_reg, pmax); alpha = __builtin_amdgcn_exp2f((m_reg - mn) * C); m_reg = mn; }
  float mnC = -mn * C;
#pragma unroll
  for (int r = 0; r < 16; ++r) p0[r] = fmaf(p0[r], C, mnC);
#pragma unroll
  for (int r = 0; r < 16; ++r) p1[r] = fmaf(p1[r], C, mnC);
#pragma unroll
  for (int r = 0; r < 16; ++r) p0[r] = __builtin_amdgcn_exp2f(p0[r]);
}
__device__ __forceinline__ void finishSM(f32x16& p0, f32x16& p1, float alpha, float& l_reg, h16x8& pa0, h16x8& pa1, h16x8& pa2, h16x8& pa3) {
#pragma unroll
  for (int r = 0; r < 16; ++r) p1[r] = __builtin_amdgcn_exp2f(p1[r]);
  float ps = 0;
#pragma unroll
  for (int r = 0; r < 16; ++r) ps += p0[r];
#pragma unroll
  for (int r = 0; r < 16; ++r) ps += p1[r];
  { auto rr = __builtin_amdgcn_permlane32_swap(__float_as_uint(ps), __float_as_uint(ps), false, false);
    ps = __uint_as_float(rr[0]) + __uint_as_float(rr[1]); }
  l_reg = l_reg * alpha + ps;
#define PK4(P, BASE, OUT) do { unsigned a0 = pkh(P[BASE + 0], P[BASE + 1]), a1 = pkh(P[BASE + 2], P[BASE + 3]);   \
    unsigned b0 = pkh(P[BASE + 4], P[BASE + 5]), b1 = pkh(P[BASE + 6], P[BASE + 7]);                              \
    auto r0 = __builtin_amdgcn_permlane32_swap(a0, b0, false, false); auto r1 = __builtin_amdgcn_permlane32_swap(a1, b1, false, false); \
    u32x4 w = {r0[0], r1[0], r0[1], r1[1]}; OUT = __builtin_bit_cast(h16x8, w); } while (0)
  PK4(p0, 0, pa0); PK4(p0, 8, pa1); PK4(p1, 0, pa2); PK4(p1, 8, pa3);
#undef PK4
}
__device__ __forceinline__ void qkt(f32x16& p0, f32x16& p1, const char* Ks, const h16x8* qr, int r32, int hi, int t) {
  p0 = f32x16{}; p1 = f32x16{};
#pragma unroll
  for (int d0 = 0; d0 < 4; ++d0) { int cb = ((t * 4 + d0) * 16 + hi * 8) * 2;
    h16x8 b0 = *reinterpret_cast<const h16x8*>(Ks + KSWZ(r32, cb));
    h16x8 b1 = *reinterpret_cast<const h16x8*>(Ks + KSWZ(32 + r32, cb));
    p0 = __builtin_amdgcn_mfma_f32_32x32x16_f16(b0, qr[d0], p0, 0, 0, 0);
    p1 = __builtin_amdgcn_mfma_f32_32x32x16_f16(b1, qr[d0], p1, 0, 0, 0); }
}
__device__ __forceinline__ int v_st(int k, int c) { const int kk = (k & ~0xC) | ((k & 4) << 1) | ((k & 8) >> 1); return ((kk >> 3) * 4 + (c >> 5)) * 512 + ((kk & 7) * 32 + (c & 31)) * 2; }
__device__ __forceinline__ int v_rd_base(int lane) { return ((lane & 3) << 3) | (((lane >> 2) & 3) << 6) | (((lane >> 4) & 1) << 5) | (((lane >> 5) & 1) << 8); }
constexpr int v_rd_off(int d0, int ks, int half) { return d0 * 512 + ks * 4096 + half * 2048; }
template <int OFF> __device__ __forceinline__ s16x4 tr_read(int vb) {
  s16x4 r; asm volatile("ds_read_b64_tr_b16 %0, %1 offset:%2" : "=&v"(r) : "v"(vb), "i"(OFF) : "memory"); return r;
}
template <int D0> __device__ __forceinline__ void pv_one(f32x16& od, int vb, h16x8 pa0, h16x8 pa1, h16x8 pa2, h16x8 pa3) {
  const s16x4 l0 = tr_read<v_rd_off(D0, 0, 0)>(vb), h0 = tr_read<v_rd_off(D0, 0, 1)>(vb), l1 = tr_read<v_rd_off(D0, 1, 0)>(vb), h1 = tr_read<v_rd_off(D0, 1, 1)>(vb);
  const s16x4 l2 = tr_read<v_rd_off(D0, 2, 0)>(vb), h2 = tr_read<v_rd_off(D0, 2, 1)>(vb), l3 = tr_read<v_rd_off(D0, 3, 0)>(vb), h3 = tr_read<v_rd_off(D0, 3, 1)>(vb);
  asm volatile("s_waitcnt lgkmcnt(0)" ::: "memory"); SBAR();
#define PKV(L, H) __builtin_bit_cast(h16x8, (__attribute__((ext_vector_type(8))) short){L[0], L[1], L[2], L[3], H[0], H[1], H[2], H[3]})
  od = __builtin_amdgcn_mfma_f32_32x32x16_f16(pa0, PKV(l0, h0), od, 0, 0, 0);
  od = __builtin_amdgcn_mfma_f32_32x32x16_f16(pa1, PKV(l1, h1), od, 0, 0, 0);
  od = __builtin_amdgcn_mfma_f32_32x32x16_f16(pa2, PKV(l2, h2), od, 0, 0, 0);
  od = __builtin_amdgcn_mfma_f32_32x32x16_f16(pa3, PKV(l3, h3), od, 0, 0, 0);
#undef PKV
}
__device__ __forceinline__ void pv_d0(f32x16* o, int vb, h16x8 pa0, h16x8 pa1, h16x8 pa2, h16x8 pa3) {
  pv_one<0>(o[0], vb, pa0, pa1, pa2, pa3); pv_one<1>(o[1], vb, pa0, pa1, pa2, pa3); pv_one<2>(o[2], vb, pa0, pa1, pa2, pa3); pv_one<3>(o[3], vb, pa0, pa1, pa2, pa3);
}

__device__ __forceinline__ void unit(const int tid, const h16* __restrict__ Qb, const h16* __restrict__ Kh, const h16* __restrict__ Vh, h16* __restrict__ Ob, int seq, char* lds,
                                     float lam, float oml, const float* __restrict__ gsub) {
  constexpr int LDK = DM, LDQ = DM, LDO = DM;
  const int wid = tid >> 6, lane = tid & 63, r32 = lane & 31, hi = lane >> 5;
  const int qg = wid & 3, th = wid >> 2;
  char* V_lds = lds; char* K_lds = lds + 2 * SHM_V;
  float* ws = (float*)(lds + 2 * SHM_V + 2 * SHM_K) + wid * 64; float* li_l = ws; float* al_l = ws + 32;
  float m_reg = -1e30f, l_reg = 0; f32x16 o[4] = {}; h16x8 qr[4];
  const h16* Qw = Qb + (long)(qg * QBLK + r32) * LDQ + th * 64 + hi * 8;
#pragma unroll
  for (int d0 = 0; d0 < 4; ++d0) qr[d0] = *reinterpret_cast<const h16x8*>(Qw + d0 * 16);
  const int sr = tid >> 4, sc = (tid & 15) * 8, vst0 = v_st(sr, sc), vst1 = v_st(32 + sr, sc);
  const int vb0 = (int)(uintptr_t)V_lds + v_rd_base(lane);
  constexpr int SDEPTH = 1;
  struct { h16x8 vs0, vs1, ks0, ks1; } sr_[SDEPTH];
#define SLOAD(i, k0) do { sr_[i].vs0 = *reinterpret_cast<const h16x8*>(&Vh[(long)((k0) + sr) * LDK + sc]); sr_[i].vs1 = *reinterpret_cast<const h16x8*>(&Vh[(long)((k0) + 32 + sr) * LDK + sc]); \
    sr_[i].ks0 = *reinterpret_cast<const h16x8*>(&Kh[(long)((k0) + sr) * LDK + sc]); sr_[i].ks1 = *reinterpret_cast<const h16x8*>(&Kh[(long)((k0) + 32 + sr) * LDK + sc]); } while (0)
#define SWRITE(b, i) do { *(h16x8*)(V_lds + (b) * SHM_V + vst0) = sr_[i].vs0;          \
    *(h16x8*)(V_lds + (b) * SHM_V + vst1) = sr_[i].vs1; int kc = sc * 2;               \
    *(h16x8*)(K_lds + (b) * SHM_K + KSWZ(sr, kc)) = sr_[i].ks0;                       \
    *(h16x8*)(K_lds + (b) * SHM_K + KSWZ(32 + sr, kc)) = sr_[i].ks1; } while (0)
#define SWAIT() do { if constexpr (SDEPTH == 2) asm volatile("s_waitcnt vmcnt(4)" ::: "memory"); else asm volatile("s_waitcnt vmcnt(0)" ::: "memory"); } while (0)
#define RESC(a) do { if (__any((a) < 1.f)) { if (hi == 0) al_l[r32] = (a); asm volatile("s_waitcnt lgkmcnt(0)" ::: "memory"); \
    _Pragma("unroll") for (int d = 0; d < 4; ++d) _Pragma("unroll") for (int r = 0; r < 16; ++r) o[d][r] *= al_l[crow(r, hi)]; } } while (0)
  f32x16 pA0, pA1, pB0, pB1; float mnA, mnB, alA, alB; h16x8 pa0, pa1, pa2, pa3; const int NT = seq / KVBLK;
  constexpr int SE = 0, SO = SDEPTH - 1;
  SLOAD(SE, 0); asm volatile("s_waitcnt vmcnt(0)" ::: "memory"); SWRITE(0, SE); __syncthreads();
  qkt(pA0, pA1, K_lds, qr, r32, hi, th); partialSM(pA0, pA1, m_reg, mnA, alA);
  SLOAD(SO, KVBLK); if constexpr (SDEPTH == 2) { if (2 < NT) SLOAD(SE, 2 * KVBLK); }
  SWAIT(); SWRITE(1, SO); __syncthreads();
  for (int j = 1; j + 1 < NT; j += 2) {
    SBAR(); qkt(pB0, pB1, K_lds + SHM_K, qr, r32, hi, th);
    finishSM(pA0, pA1, alA, l_reg, pa0, pa1, pa2, pa3); SBAR();
    SLOAD(SO, (j + SDEPTH) * KVBLK); SBAR();
    pv_d0(o, vb0, pa0, pa1, pa2, pa3); partialSM(pB0, pB1, m_reg, mnB, alB);
    __syncthreads(); SWAIT(); SWRITE(0, SE);
    RESC(alB); __syncthreads();
    SBAR(); qkt(pA0, pA1, K_lds, qr, r32, hi, th);
    finishSM(pB0, pB1, alB, l_reg, pa0, pa1, pa2, pa3); SBAR();
    if (SDEPTH == 1 || j + 3 < NT) SLOAD(SE, (j + 1 + SDEPTH) * KVBLK); SBAR();
    pv_d0(o, vb0 + (int)SHM_V, pa0, pa1, pa2, pa3); partialSM(pA0, pA1, m_reg, mnA, alA);
    __syncthreads(); SWAIT(); SWRITE(1, SO);
    RESC(alA); __syncthreads();
  }
  SBAR(); qkt(pB0, pB1, K_lds + SHM_K, qr, r32, hi, th);
  finishSM(pA0, pA1, alA, l_reg, pa0, pa1, pa2, pa3); SBAR();
  pv_d0(o, vb0, pa0, pa1, pa2, pa3); partialSM(pB0, pB1, m_reg, mnB, alB);
  __syncthreads(); RESC(alB);
  finishSM(pB0, pB1, alB, l_reg, pa0, pa1, pa2, pa3); SBAR();
  pv_d0(o, vb0 + (int)SHM_V, pa0, pa1, pa2, pa3);
  if (hi == 0) li_l[r32] = l_reg; asm volatile("s_waitcnt lgkmcnt(0)" ::: "memory");
  float rli[16];
#pragma unroll
  for (int r = 0; r < 16; ++r) rli[r] = __builtin_amdgcn_rcpf(li_l[crow(r, hi)]);
  __syncthreads();
  float* X = (float*)lds + qg * 4096;
  if (th == 1) {
#pragma unroll
    for (int r = 0; r < 16; ++r)
#pragma unroll
      for (int d0 = 0; d0 < 4; ++d0) X[(r * 4 + d0) * 64 + lane] = o[d0][r] * rli[r] * (-lam);
  }
  __syncthreads();
  if (th == 0) {
    float gv[4];
#pragma unroll
    for (int d0 = 0; d0 < 4; ++d0) gv[d0] = gsub[d0 * 32 + r32] * oml;
    h16* Ow = Ob + (long)(qg * QBLK) * LDO;
#pragma unroll
    for (int r = 0; r < 16; ++r) {
      float v[4], ss = 0.f;
#pragma unroll
      for (int d0 = 0; d0 < 4; ++d0) { v[d0] = o[d0][r] * rli[r] + X[(r * 4 + d0) * 64 + lane]; ss += v[d0] * v[d0]; }
      ss += __shfl_xor(ss, 1); ss += __shfl_xor(ss, 2); ss += __shfl_xor(ss, 4); ss += __shfl_xor(ss, 8); ss += __shfl_xor(ss, 16);
      const float rs = rsqrtf(ss * (1.f / 128.f) + SUBLN_EPS);
      const int orow = crow(r, hi);
#pragma unroll
      for (int d0 = 0; d0 < 4; ++d0) Ow[(long)orow * LDO + d0 * 32 + r32] = (h16)(v[d0] * rs * gv[d0]);
    }
  }
  __syncthreads();
#undef SLOAD
#undef SWRITE
#undef SWAIT
#undef RESC
}
#undef SBAR
}

#define XB_TMO      128
#define XB_XCNT(j)  (256  + 64 * (j))
#define XB_XSUB(j)  (1280 + 64 * (j))
#define XB_XGEN(j)  (2304 + 64 * (j))
#define XB_TOP      3328
#define XB_TOPGEN   3392
#define XCD_BAR_WORDS 3456
#define XB_SPIN_CAP (1u << 20)
__device__ __forceinline__ unsigned xb_ld(unsigned* p)              { return __hip_atomic_load(p, __ATOMIC_RELAXED, __HIP_MEMORY_SCOPE_AGENT); }
__device__ __forceinline__ unsigned xb_add(unsigned* p, unsigned v) { return __hip_atomic_fetch_add(p, v, __ATOMIC_RELAXED, __HIP_MEMORY_SCOPE_AGENT); }
__device__ __forceinline__ unsigned xb_xcc_id() { return (unsigned)__builtin_amdgcn_s_getreg((3 << 11) | 20) & 0xFu; }
#define XB_SPIN(cond, bar) do { unsigned _sp = 0; while (cond) { __builtin_amdgcn_s_sleep(1); \
    if ((++_sp & 255u) == 0u) { if (xb_ld(&(bar)[XB_TMO])) break; if (_sp > XB_SPIN_CAP) { atomicAdd(&(bar)[XB_TMO], 1u); break; } } } } while (0)
struct XcdBarrier { unsigned* bar; unsigned x; volatile LAS unsigned* st; };
__device__ __forceinline__ XcdBarrier xcd_barrier_post(unsigned* bar, volatile LAS unsigned* st) {
    XcdBarrier b; b.bar = bar; b.x = xb_xcc_id(); b.st = st;
    if (threadIdx.x == 0) (void)xb_add(&bar[XB_XCNT(b.x)], 1u);
    return b;
}
__device__ __forceinline__ void xcd_barrier_complete(unsigned* bar, unsigned x, unsigned& nloc, unsigned& nx) {
    const unsigned G = gridDim.x * gridDim.y * gridDim.z;
    unsigned sum, cnt, mine, sp = 0u;
    for (;;) {
        sum = 0u; cnt = 0u; mine = 0u;
#pragma unroll
        for (unsigned j = 0; j < 16; ++j) { const unsigned c = xb_ld(&bar[XB_XCNT(j)]); sum += c; cnt += (c > 0u) ? 1u : 0u; mine = (j == x) ? c : mine; }
        if (sum == G) break;
        __builtin_amdgcn_s_sleep(1);
        if ((++sp & 255u) == 0u) { if (xb_ld(&bar[XB_TMO])) break; if (sp > XB_SPIN_CAP) { atomicAdd(&bar[XB_TMO], 1u); break; } }
    }
    nloc = mine > 0u ? mine : 1u; nx = cnt > 0u ? cnt : 1u;
}
__device__ __forceinline__ void xcd_barrier(const XcdBarrier& b) {
    asm volatile("s_waitcnt vmcnt(0)" ::: "memory");
    __syncthreads();
    if (threadIdx.x == 0) {
        unsigned* bar = b.bar;
        __builtin_amdgcn_s_waitcnt(0);
        unsigned nloc = b.st[0], nx = b.st[1];
        if (nloc == 0u) { xcd_barrier_complete(bar, b.x, nloc, nx); b.st[0] = nloc; b.st[1] = nx; }
        const unsigned old = xb_add(&bar[XB_XSUB(b.x)], 1u);
        const unsigned gen = old / nloc;
        if (old + 1u == (gen + 1u) * nloc) {
            __builtin_amdgcn_fence(__ATOMIC_RELEASE, "agent");
            asm volatile("s_waitcnt vmcnt(0)" ::: "memory");
            const unsigned og = xb_add(&bar[XB_TOP], 1u);
            const unsigned tg = og / nx;
            if (og + 1u == (tg + 1u) * nx) xb_add(&bar[XB_TOPGEN], 1u);
            else XB_SPIN(xb_ld(&bar[XB_TOPGEN]) == tg, bar);
            __builtin_amdgcn_fence(__ATOMIC_ACQUIRE, "agent");
            xb_add(&bar[XB_XGEN(b.x)], 1u);
            asm volatile("s_waitcnt vmcnt(0)" ::: "memory");
        } else {
            XB_SPIN(xb_ld(&bar[XB_XGEN(b.x)]) == gen, bar);
            __builtin_amdgcn_fence(__ATOMIC_ACQUIRE, "agent");
            asm volatile("s_waitcnt vmcnt(0)" ::: "memory");
        }
    }
    __syncthreads();
}

struct Args { const float* in[24]; float* out; unsigned char* ws; int s_lo, s_hi; };
enum { I_XP = 0, I_XS, I_CK, I_CV, I_C, I_CCTX, I_WADA, I_BADA, I_WF, I_WQKV, I_LQ1, I_LK1, I_LQ2, I_LK2, I_SUBG, I_WO, I_WUP, I_CONVW, I_CONVB, I_WDN, I_LN1G, I_LN1B, I_LN2G, I_LN2B };

struct Frame {
    LAS unsigned char* lds; char* ldsg;
    int tid, lane, wave, vcu, G;
};
__device__ __forceinline__ float wave_sum(float v) {
#pragma unroll
    for (int o = 1; o < 64; o <<= 1) v += __shfl_xor(v, o);
    return v;
}
__device__ __forceinline__ void transpose_item(const float* W, int K, int N, h16* WT, LAS float* scr, int item, int lane) {
    const int nblk = N / 32, kb = item / nblk, nb = item % nblk, k0 = 64 * kb, n0 = 32 * nb;
#pragma unroll 8
    for (int i = 0; i < 32; ++i) { const int kk = 2 * i + (lane >> 5); scr[kk * 33 + (lane & 31)] = W[(size_t)(k0 + kk) * N + n0 + (lane & 31)]; }
    asm volatile("s_waitcnt lgkmcnt(0)" ::: "memory");
    const int c = lane & 7;
#pragma unroll
    for (int j = 0; j < 4; ++j) { const int n = (lane >> 3) + 8 * j; const LAS float* s = scr + (8 * c) * 33 + n;
        u32x4 o; o.x = pkh(s[0 * 33], s[1 * 33]); o.y = pkh(s[2 * 33], s[3 * 33]); o.z = pkh(s[4 * 33], s[5 * 33]); o.w = pkh(s[6 * 33], s[7 * 33]);
        *(u32x4*)(WT + (size_t)(n0 + n) * K + k0 + 8 * c) = o; }
    asm volatile("s_waitcnt lgkmcnt(0)" ::: "memory");
}
__device__ __forceinline__ float silu_f(float x) { return x / (1.f + __expf(-x)); }

__device__ __forceinline__ void step_prep(const Frame& F, const Args& a, int L, bool first) {
    unsigned char* ws = a.ws;
    const int gw = F.vcu * 8 + F.wave, NGW = F.G * 8;
    if (first) {
        LAS float* S = (LAS float*)F.lds;
        LAS float* red = (LAS float*)(F.lds + 20480);
        if (F.vcu < 384) {
            for (int i = F.tid; i < 5 * 1024; i += 512) { const int cd = i >> 10, k = i & 1023; const float x = cd == 0 ? a.in[I_CCTX][k] : a.in[I_C][(cd - 1) * 1024 + k]; S[i] = silu_f(x); }
            __syncthreads();
            for (int it = F.vcu; it < 384; it += F.G) {
                const int Ly = it / 96, ch = it % 96; const int cq = F.lane & 15, kg = F.lane >> 4;
                const float* Wp = a.in[I_WADA] + (size_t)Ly * 1024 * 6144 + ch * 64 + cq * 4;
                f32x4 acc[5];
#pragma unroll
                for (int c = 0; c < 5; ++c) acc[c] = (f32x4){0.f, 0.f, 0.f, 0.f};
#pragma unroll 4
                for (int i = 0; i < 32; ++i) { const int k = F.wave * 128 + 4 * i + kg; const f32x4 w = *(const f32x4*)(Wp + (size_t)k * 6144);
#pragma unroll
                    for (int c = 0; c < 5; ++c) acc[c] += w * S[c * 1024 + k]; }
#pragma unroll
                for (int c = 0; c < 5; ++c)
#pragma unroll
                    for (int e = 0; e < 4; ++e) { float v = acc[c][e]; v += __shfl_xor(v, 16); v += __shfl_xor(v, 32); acc[c][e] = v; }
                if (kg == 0) {
#pragma unroll
                    for (int c = 0; c < 5; ++c)
#pragma unroll
                        for (int e = 0; e < 4; ++e) red[(F.wave * 5 + c) * 64 + cq * 4 + e] = acc[c][e]; }
                __syncthreads();
                if (F.tid < 320) { const int c = F.tid >> 6, col = F.tid & 63; float s = a.in[I_BADA][Ly * 6144 + ch * 64 + col];
#pragma unroll
                    for (int w = 0; w < 8; ++w) s += red[(w * 5 + c) * 64 + col];
                    ((float*)(ws + WS_ADA))[(Ly * 5 + c) * 6144 + ch * 64 + col] = s; }
                __syncthreads();
            }
        }
        if (F.vcu == 0) {
            float* rope = (float*)(ws + WS_ROPE);
            for (int i = F.tid; i < 1024; i += 512) { const int pos = i >> 4, f = i & 15; const float inv = exp2f(-(float)f * (13.287712379549449f / 16.f)); const float ang = (float)pos * inv;
                rope[i] = cosf(ang); rope[1024 + i] = sinf(ang); }
            if (F.tid < 2) { const int j = F.tid; float s1 = 0.f, s2 = 0.f;
                for (int d = 0; d < 64; ++d) { s1 += a.in[I_LQ1][j * 64 + d] * a.in[I_LK1][j * 64 + d]; s2 += a.in[I_LQ2][j * 64 + d] * a.in[I_LK2][j * 64 + d]; }
                const float li = 0.8f - 0.6f * expf(-0.3f * (float)(2 * j + 1));
                rope[2048 + j] = expf(s1) - expf(s2) + li; rope[2050 + j] = 1.f - li; }
        }
        {
            const int gt = F.vcu * 512 + F.tid, NGT = F.G * 512;
            h16* d256 = (h16*)(ws + WS_D256); h16* d2k = (h16*)(ws + WS_D2048);
            for (int it = gt; it < 3 * 256 * 32; it += NGT) { const int mat = it / (256 * 32), j = (it / 32) % 256, k0 = (it % 32) * 8; float v[8];
#pragma unroll
                for (int e = 0; e < 8; ++e) { const int m = (j * (k0 + e)) & 255; const float x = (float)m * (1.f / 128.f); v[e] = (mat == 0 ? cospif(x) : (mat == 1 ? -sinpif(x) : sinpif(x))) * 0.0625f; }
                u32x4 o = {pkh(v[0], v[1]), pkh(v[2], v[3]), pkh(v[4], v[5]), pkh(v[6], v[7])}; *(u32x4*)(d256 + (size_t)it * 8) = o; }
            for (int it = gt; it < 2 * 2048 * 256; it += NGT) { const int mat = it / (2048 * 256), j = (it / 256) % 2048, k0 = (it % 256) * 8; float v[8];
#pragma unroll
                for (int e = 0; e < 8; ++e) { const int m = (j * (k0 + e)) & 2047; const float x = (float)m * (1.f / 1024.f); v[e] = (mat == 0 ? cospif(x) : sinpif(x)) * 0.022097086912079608f; }
                u32x4 o = {pkh(v[0], v[1]), pkh(v[2], v[3]), pkh(v[4], v[5]), pkh(v[6], v[7])}; *(u32x4*)(d2k + (size_t)it * 8) = o; }
        }
        __syncthreads();
    }
    LAS float* scr = (LAS float*)(F.lds + F.wave * 16384);
    const bool att = (L & 1) != 0; const int j = L >> 1;
    const int I_UP = (1024 / 64) * (DFF2 / 32), I_DN = (DFF / 64) * (1024 / 32), I_QKV = att ? (1024 / 64) * (3072 / 32) : 0, I_O = att ? 512 : 0, I_F = first ? 1024 : 0, I_CR = att ? 2 * NBL * PAST : 0;
    const int NIT = I_UP + I_DN + I_QKV + I_O + I_F + I_CR;
    for (int it = gw; it < NIT; it += NGW) {
        int r = it;
        if (r < I_UP) { transpose_item(a.in[I_WUP] + (size_t)L * 1024 * DFF2, 1024, DFF2, (h16*)(ws + WS_WUP), scr, r, F.lane); continue; } r -= I_UP;
        if (r < I_DN) { transpose_item(a.in[I_WDN] + (size_t)L * DFF * 1024, DFF, 1024, (h16*)(ws + WS_WDN), scr, r, F.lane); continue; } r -= I_DN;
        if (r < I_QKV) { transpose_item(a.in[I_WQKV] + (size_t)j * 1024 * 3072, 1024, 3072, (h16*)(ws + WS_WQKV), scr, r, F.lane); continue; } r -= I_QKV;
        if (r < I_O) { transpose_item(a.in[I_WO] + (size_t)j * 1024 * 1024, 1024, 1024, (h16*)(ws + WS_WO), scr, r, F.lane); continue; } r -= I_O;
        if (r < I_F) { const int ly = r >> 9; transpose_item(a.in[I_WF] + (size_t)ly * 1024 * 1024, 1024, 1024, (h16*)(ws + WS_WFT) + (size_t)ly * 1024 * 1024, scr, r & 511, F.lane); continue; } r -= I_F;
        { const int kv = r / (NBL * PAST), rr = r % (NBL * PAST), b = rr / PAST, p = rr % PAST;
          const float* src = a.in[kv ? I_CV : I_CK] + ((size_t)(b * 2 + j) * PAST + p) * DM; h16* dst = (h16*)(ws + (kv ? WS_V : WS_K)) + ((size_t)NCTX + (size_t)b * KVL + SEQL + p) * DM;
#pragma unroll
          for (int q = 0; q < 4; ++q) { const f32x4 v = *(const f32x4*)(src + q * 256 + F.lane * 4); u32x2 o = {pkh(v[0], v[1]), pkh(v[2], v[3])}; *(u32x2*)(dst + q * 256 + F.lane * 4) = o; } }
    }
}

__device__ __forceinline__ void step_ln(const Frame& F, const Args& a, int mode, int L, bool two_u) {
    unsigned char* ws = a.ws;
    const int gw = F.vcu * 8 + F.wave, NGW = F.G * 8;
    const float* ada = (const float*)(ws + WS_ADA);
    const h16* U0 = (const h16*)(ws + WS_U0); const h16* U1 = (const h16*)(ws + WS_U1); h16* H = (h16*)(ws + WS_H);
    const bool from_in = (mode == 0) || (mode == 1 && L == 0);
    const bool has_h = !(mode == 2 && L == DEPTH - 1);
    const int Lh = (mode == 2) ? L + 1 : L;
    const int jsh = (mode == 1) ? 3 : 0, jsc = jsh + 1, jg = (mode == 1) ? 2 : 5;
    const float* lng = a.in[mode == 1 ? I_LN1G : I_LN2G] + L * DM; const float* lnb = a.in[mode == 1 ? I_LN1B : I_LN2B] + L * DM;
    for (int chunk = gw; chunk < NTOK / 8; chunk += NGW) {
        const int row0 = chunk * 8; const int cond = row0 < NCTX ? 0 : 1 + ((row0 - NCTX) >> 11);
        f32x4 gate[4], vg[4], vb[4], vsc[4], vsh[4];
#pragma unroll
        for (int q = 0; q < 4; ++q) { const int c = q * 256 + F.lane * 4;
            if (mode != 0) { gate[q] = *(const f32x4*)(ada + (size_t)(L * 5 + cond) * 6144 + jg * 1024 + c); vg[q] = *(const f32x4*)(lng + c); vb[q] = *(const f32x4*)(lnb + c); }
            if (has_h) { vsc[q] = *(const f32x4*)(ada + (size_t)(Lh * 5 + cond) * 6144 + jsc * 1024 + c) + 1.f; vsh[q] = *(const f32x4*)(ada + (size_t)(Lh * 5 + cond) * 6144 + jsh * 1024 + c); } }
        for (int rr = 0; rr < 8; ++rr) {
            const int row = row0 + rr;
            const float* xr = from_in ? (row < NCTX ? a.in[I_XP] + (size_t)row * DM : a.in[I_XS] + (size_t)(row - NCTX) * DM) : a.out + (size_t)row * DM;
            f32x4 v[4];
#pragma unroll
            for (int q = 0; q < 4; ++q) v[q] = *(const f32x4*)(xr + q * 256 + F.lane * 4);
            if (mode != 0) {
                float s = 0.f;
#pragma unroll
                for (int q = 0; q < 4; ++q) { const h16x4 u = *(const h16x4*)(U0 + (size_t)row * DM + q * 256 + F.lane * 4); f32x4 uf = __builtin_convertvector(u, f32x4);
                    if (two_u) { const h16x4 u1 = *(const h16x4*)(U1 + (size_t)row * DM + q * 256 + F.lane * 4); uf += __builtin_convertvector(u1, f32x4); }
                    v[q] = v[q] * DN_ALPHA + gate[q] * uf; s += (v[q].x + v[q].y) + (v[q].z + v[q].w); }
                const float mean = wave_sum(s) * (1.f / DM); float s2 = 0.f;
#pragma unroll
                for (int q = 0; q < 4; ++q) { v[q] = v[q] - mean; s2 += (v[q].x * v[q].x + v[q].y * v[q].y) + (v[q].z * v[q].z + v[q].w * v[q].w); }
                const float rstd = rsqrtf(wave_sum(s2) * (1.f / DM) + LN_EPS);
#pragma unroll
                for (int q = 0; q < 4; ++q) { v[q] = v[q] * rstd * vg[q] + vb[q]; *(f32x4*)(a.out + (size_t)row * DM + q * 256 + F.lane * 4) = v[q]; }
            }
            if (has_h) {
                float s = 0.f;
#pragma unroll
                for (int q = 0; q < 4; ++q) s += (v[q].x + v[q].y) + (v[q].z + v[q].w);
                const float mean = wave_sum(s) * (1.f / DM); float s2 = 0.f;
#pragma unroll
                for (int q = 0; q < 4; ++q) { v[q] = v[q] - mean; s2 += (v[q].x * v[q].x + v[q].y * v[q].y) + (v[q].z * v[q].z + v[q].w * v[q].w); }
                const float rstd = rsqrtf(wave_sum(s2) * (1.f / DM) + LN_EPS);
#pragma unroll
                for (int q = 0; q < 4; ++q) { const f32x4 h = v[q] * rstd * vsc[q] + vsh[q]; u32x2 o = {pkh(h[0], h[1]), pkh(h[2], h[3])}; *(u32x2*)(H + (size_t)row * DM + q * 256 + F.lane * 4) = o; }
            }
        }
    }
}

__device__ __forceinline__ void step_convgate(const Frame& F, const Args& a, int L) {
    unsigned char* ws = a.ws;
    const int gw = F.vcu * 8 + F.wave, NGW = F.G * 8;
    h16* UU = (h16*)(ws + WS_ARENA); const h16* HALO = (const h16*)(ws + WS_HALO);
    const float* cw = a.in[I_CONVW] + (size_t)L * 3 * DFF2; const float* cb = a.in[I_CONVB] + (size_t)L * DFF2;
    const int rg = F.lane >> 4, cl = F.lane & 15;
    for (int it = gw; it < 64 * 22; it += NGW) {
        const int pm = it / 22, cg = it % 22; const int col = cg * 128 + cl * 8;
        const bool lat = pm >= 32; const int pml = lat ? (pm - 32) & 7 : 0;
        const bool has_prev_tile = lat && pml > 0, has_next_tile = lat && pml < 7;
        float w[2][3][8], bb[2][8];
#pragma unroll
        for (int p = 0; p < 2; ++p) {
#pragma unroll
            for (int d = 0; d < 3; ++d) { const f32x4 x0 = *(const f32x4*)(cw + d * DFF2 + p * DFF + col), x1 = *(const f32x4*)(cw + d * DFF2 + p * DFF + col + 4);
#pragma unroll
                for (int e = 0; e < 4; ++e) { w[p][d][e] = x0[e]; w[p][d][4 + e] = x1[e]; } }
            const f32x4 y0 = *(const f32x4*)(cb + p * DFF + col), y1 = *(const f32x4*)(cb + p * DFF + col + 4);
#pragma unroll
            for (int e = 0; e < 4; ++e) { bb[p][e] = y0[e]; bb[p][4 + e] = y1[e]; } }
        const int r0 = rg * 64;
        h16* base = UU + (size_t)pm * 256 * DFF2 + col;
        h16x8 prv[2], cur[2], nxt[2], endh[2];
        const h16x8 zero = {0, 0, 0, 0, 0, 0, 0, 0};
#pragma unroll
        for (int p = 0; p < 2; ++p) {
            if (rg > 0) prv[p] = *(const h16x8*)(base + (size_t)(r0 - 1) * DFF2 + p * DFF);
            else if (has_prev_tile) prv[p] = *(const h16x8*)(HALO + ((size_t)(pm - 1) * 2 + 1) * DFF2 + p * DFF + col);
            else prv[p] = zero;
            if (rg < 3) endh[p] = *(const h16x8*)(base + (size_t)(r0 + 64) * DFF2 + p * DFF);
            else if (has_next_tile) endh[p] = *(const h16x8*)(HALO + ((size_t)(pm + 1) * 2 + 0) * DFF2 + p * DFF + col);
            else endh[p] = zero;
            cur[p] = *(const h16x8*)(base + (size_t)r0 * DFF2 + p * DFF);
        }
        asm volatile("s_waitcnt vmcnt(0)" ::: "memory");
        for (int s = 0; s < 64; ++s) {
#pragma unroll
            for (int p = 0; p < 2; ++p) nxt[p] = (s < 63) ? *(const h16x8*)(base + (size_t)(r0 + s + 1) * DFF2 + p * DFF) : endh[p];
            float av[8], gv[8];
#pragma unroll
            for (int e = 0; e < 8; ++e) {
                av[e] = w[0][0][e] * (float)prv[0][e] + w[0][1][e] * (float)cur[0][e] + w[0][2][e] * (float)nxt[0][e] + bb[0][e];
                gv[e] = w[1][0][e] * (float)prv[1][e] + w[1][1][e] * (float)cur[1][e] + w[1][2][e] * (float)nxt[1][e] + bb[1][e];
                av[e] = av[e] / (1.f + __expf(-av[e])) * gv[e]; }
            u32x4 o = {pkh(av[0], av[1]), pkh(av[2], av[3]), pkh(av[4], av[5]), pkh(av[6], av[7])};
            *(u32x4*)(base + (size_t)(r0 + s) * DFF2) = o;
#pragma unroll
            for (int p = 0; p < 2; ++p) { prv[p] = cur[p]; cur[p] = nxt[p]; }
        }
    }
}

__device__ __forceinline__ void step_attn(const Frame& F, const Args& a, int L) {
    unsigned char* ws = a.ws; const int j = L >> 1;
    const h16* Q = (const h16*)(ws + WS_Q); const h16* K = (const h16*)(ws + WS_K); const h16* V = (const h16*)(ws + WS_V); h16* O = (h16*)(ws + WS_O);
    const float* lamp = (const float*)(ws + WS_ROPE) + 2048; const float lam = lamp[j], oml = lamp[2 + j];
    const float* gsub = a.in[I_SUBG] + j * 128;
    for (int it = F.vcu; it < 1024; it += F.G) {
        int kind, id;
        if (F.G == 256) { kind = (it >> 8) & 1; id = ((it >> 9) << 8) + (it & 255); }
        else { kind = it >= 512; id = it & 511; }
        size_t qrow, krow; int h, seq;
        if (kind == 0) { const int bh = id >> 4, qb = id & 15, b = bh >> 3; h = bh & 7; qrow = (size_t)NCTX + (size_t)b * SEQL + qb * 128; krow = (size_t)NCTX + (size_t)b * KVL; seq = KVL; }
        else { const int bh = id >> 1, qb = id & 1, b = bh >> 3; h = bh & 7; qrow = (size_t)b * SEQC + qb * 128; krow = (size_t)b * SEQC; seq = SEQC; }
        attn::unit(F.tid, Q + qrow * DM + h * 128, K + krow * DM + h * 128, V + krow * DM + h * 128, O + qrow * DM + h * 128, seq, F.ldsg, lam, oml, gsub);
    }
}

enum { K_PREP0 = 0, K_GEMM, K_QKV, K_LN, K_CG, K_ATT };
enum { GV_WP = 0, GV_FA, GV_FBL, GV_FBC, GV_O, GV_UP, GV_DN };
constexpr int NSTEPS = 3 + 8 * DEPTH;

__global__ void __launch_bounds__(512, 2) dit_fwd(Args args) {
    extern __shared__ __attribute__((aligned(16))) unsigned char lds_raw[];
    unsigned char* ws = args.ws;
    volatile LAS unsigned* MISC = (volatile LAS unsigned*)((LAS unsigned char*)lds_raw + MISC_OFF);
    for (int u = threadIdx.x; u < (LDS_BYTES - LDSCTL_OFF) / 4; u += 512) ((LAS unsigned*)((LAS unsigned char*)lds_raw + LDSCTL_OFF))[u] = 0u;
    __syncthreads();
#if !MK_PER_STEP_LAUNCH
    XcdBarrier bar = xcd_barrier_post((unsigned*)(ws + WS_CTL) + CW_BAR, MISC + 8);
#endif
    for (int s = args.s_lo; s < args.s_hi; ++s) {
        Frame F;
        { int t_ = threadIdx.x; asm volatile("" : "+v"(t_)); F.tid = t_; }
        F.lds = (LAS unsigned char*)lds_raw; F.ldsg = (char*)lds_raw;
        F.lane = F.tid & 63; F.wave = __builtin_amdgcn_readfirstlane(F.tid >> 6);
        F.G = gridDim.x; { const int bx = blockIdx.x; F.vcu = (F.G % 8 == 0) ? (bx % 8) * (F.G / 8) + bx / 8 : bx; }
        int kind, L = 0, var = 0, mode = 0; bool sync_after = true, two_u = false;
        if (s == 0) kind = K_PREP0;
        else if (s == 1) { kind = K_GEMM; var = GV_WP; sync_after = false; }
        else if (s == 2) { kind = K_LN; mode = 0; }
        else { const int q = s - 3; L = q >> 3; const int jj = q & 7; const bool att = (L & 1) != 0;
            switch (jj) {
                case 0: if (att) kind = K_QKV; else { kind = K_GEMM; var = GV_FA; } break;
                case 1: if (att) kind = K_ATT; else { kind = K_GEMM; var = GV_FBL; sync_after = false; } break;
                case 2: kind = K_GEMM; var = att ? GV_O : GV_FBC; break;
                case 3: kind = K_LN; mode = 1; two_u = !att; break;
                case 4: kind = K_GEMM; var = GV_UP; break;
                case 5: kind = K_CG; break;
                case 6: kind = K_GEMM; var = GV_DN; break;
                default: kind = K_LN; mode = 2; break;
            }
        }
        if (kind == K_PREP0) { step_prep(F, args, 0, true); }
        else if (kind == K_GEMM) {
            pg8::GSched S; S.G = F.G; S.c = (int)blockIdx.x; S.n0 = 1; S.n1 = 1;
            for (int i = 0; i < 3; ++i) { S.as[i] = 0; S.bs[i] = 0; S.os[i] = 0; }
            int K = 1024; h16* halo = nullptr;
            if (var == GV_WP) { S.nM = 4; S.nN = 1; S.n0 = 4; S.n1 = 2; S.A = (const char*)(ws + WS_WFT); S.B = (const char*)(ws + WS_D256); S.O = (h16*)(ws + WS_WPT);
                S.lda = 1024; S.ldb = 256; S.ldc = 1024; K = 256;
                S.as[0] = 256 * 2; S.bs[0] = 0; S.os[0] = 256;
                S.as[1] = 0; S.bs[1] = 256 * 256 * 2; S.os[1] = 1024 * 1024;
                S.as[2] = 1024 * 1024 * 2; S.bs[2] = 0; S.os[2] = 2048 * 1024;
                S.total = 4 * 1 * 4 * 2 * 2; }
            else if (var == GV_FA) { S.nM = 8; S.nN = 64; S.A = (const char*)(ws + WS_WPT) + (size_t)(L >> 1) * 2048 * 1024 * 2; S.B = (const char*)(ws + WS_H); S.O = (h16*)(ws + WS_ARENA);
                S.lda = 1024; S.ldb = 1024; S.ldc = NTOK; K = 1024; S.total = 512; }
            else if (var == GV_FBL) { S.nM = 8; S.nN = 4; S.n0 = 4; S.n1 = 2; S.A = (const char*)(ws + WS_D2048); S.B = (const char*)(ws + WS_ARENA) + (size_t)NCTX * 2; S.O = (h16*)(ws + WS_U0) + (size_t)NCTX * DM;
                S.lda = 2048; S.ldb = NTOK; S.ldc = DM; K = 2048;
                S.as[0] = 0; S.bs[0] = 2048 * 2; S.os[0] = 2048 * DM;
                S.as[1] = 2048L * 2048 * 2; S.bs[1] = 1024L * NTOK * 2; S.os[1] = (long)NTOK * DM;
                S.total = 32 * 8; }
            else if (var == GV_FBC) { S.nM = 1; S.nN = 4; S.n0 = 32; S.n1 = 2; S.A = (const char*)(ws + WS_D256); S.B = (const char*)(ws + WS_ARENA); S.O = (h16*)(ws + WS_U0);
                S.lda = 256; S.ldb = NTOK; S.ldc = DM; K = 256;
                S.as[0] = 0; S.bs[0] = 256 * 2; S.os[0] = 256 * DM;
                S.as[1] = 2 * 256 * 256 * 2; S.bs[1] = 1024L * NTOK * 2; S.os[1] = (long)NTOK * DM;
                S.total = 4 * 64; }
            else if (var == GV_O) { S.nM = 64; S.nN = 4; S.A = (const char*)(ws + WS_O); S.B = (const char*)(ws + WS_WO); S.O = (h16*)(ws + WS_U0); S.lda = 1024; S.ldb = 1024; S.ldc = DM; K = 1024; S.total = 256; }
            else if (var == GV_UP) { S.nM = 64; S.nN = 22; S.A = (const char*)(ws + WS_H); S.B = (const char*)(ws + WS_WUP); S.O = (h16*)(ws + WS_ARENA); S.lda = 1024; S.ldb = 1024; S.ldc = DFF2; K = 1024; S.total = 64 * 22;
                halo = (h16*)(ws + WS_HALO); }
            else { S.nM = 64; S.nN = 4; S.A = (const char*)(ws + WS_ARENA); S.B = (const char*)(ws + WS_WDN); S.O = (h16*)(ws + WS_U0); S.lda = DFF2; S.ldb = DFF; S.ldc = DM; K = DFF; S.total = 256; }
            S.nwg = S.nM * S.nN;
            pg8::EpiStore16 E{S.ldc, halo};
            pg8::gemm_phase<pg8::EpiStore16, pg8::GSched>(F.lds, F.tid, K, S.lda, S.ldb, S, E);
        }
        else if (kind == K_QKV) {
            pg8::GSched S; S.G = F.G; S.c = (int)blockIdx.x; S.n0 = 1; S.n1 = 1;
            for (int i = 0; i < 3; ++i) { S.as[i] = 0; S.bs[i] = 0; S.os[i] = 0; }
            S.nM = 64; S.nN = 12; S.nwg = 768; S.total = 768; S.A = (const char*)(ws + WS_H); S.B = (const char*)(ws + WS_WQKV); S.O = nullptr; S.lda = 1024; S.ldb = 1024; S.ldc = DM;
            pg8::EpiQKV E{(h16*)(ws + WS_Q), (h16*)(ws + WS_K), (h16*)(ws + WS_V), args.out + 16777216, args.out + 33554432, (const float*)(ws + WS_ROPE), L >> 1};
            pg8::gemm_phase<pg8::EpiQKV, pg8::GSched>(F.lds, F.tid, 1024, 1024, 1024, S, E);
        }
        else if (kind == K_LN) {
            step_ln(F, args, mode, L, two_u);
            if (mode == 2 && L + 1 < DEPTH) step_prep(F, args, L + 1, false);
        }
        else if (kind == K_CG) { step_convgate(F, args, L); }
        else { step_attn(F, args, L); }
#if !MK_PER_STEP_LAUNCH
        if (sync_after && s + 1 < args.s_hi) xcd_barrier(bar);
        else __syncthreads();
#else
        (void)sync_after; __syncthreads();
#endif
    }
}

extern "C" void kernel_launch(void* const* d_in, const int* in_sizes, int n_in, void* d_out, int out_size, void* d_ws, size_t ws_size, hipStream_t stream) {
    static int grid = 0;
    if (grid == 0) {
        if (n_in != 24 || out_size != 50331648 || ws_size < WS_END) { fprintf(stderr, "kernel_launch: unexpected shapes: n_in %d out %d ws %zu (need %zu)\n", n_in, out_size, ws_size, (size_t)WS_END); grid = -1; return; }
        int dev = 0, cus = 0, per_cu = 0;
        if (hipGetDevice(&dev) != hipSuccess || hipDeviceGetAttribute(&cus, hipDeviceAttributeMultiprocessorCount, dev) != hipSuccess) { grid = -1; return; }
        if (hipFuncSetAttribute((const void*)dit_fwd, hipFuncAttributeMaxDynamicSharedMemorySize, LDS_BYTES) != hipSuccess) { fprintf(stderr, "kernel_launch: hipFuncSetAttribute failed\n"); grid = -1; return; }
        if (hipOccupancyMaxActiveBlocksPerMultiprocessor(&per_cu, (const void*)dit_fwd, 512, LDS_BYTES) != hipSuccess || per_cu < 1) { fprintf(stderr, "kernel_launch: occupancy query says %d\n", per_cu); per_cu = 1; }
        (void)hipGetLastError();
        grid = cus * (per_cu < 1 ? per_cu : 1);
    }
    if (grid < 0) return;
    (void)hipMemsetAsync((char*)d_ws + WS_CTL, 0, CTL_ZERO_BYTES, stream);
    Args a{};
    for (int i = 0; i < 24; ++i) a.in[i] = (const float*)d_in[i];
    a.out = (float*)d_out; a.ws = (unsigned char*)d_ws;
#if MK_PER_STEP_LAUNCH
    for (int s = 0; s < NSTEPS; ++s) { a.s_lo = s; a.s_hi = s + 1; hipLaunchKernelGGL(dit_fwd, dim3(grid), dim3(512), LDS_BYTES, stream, a); }
#else
    a.s_lo = 0; a.s_hi = NSTEPS;
    { void* kargs[] = {&a};
      if (hipLaunchCooperativeKernel((const void*)dit_fwd, dim3(grid), dim3(512), kargs, LDS_BYTES, stream) != hipSuccess) {
          (void)hipGetLastError(); hipLaunchKernelGGL(dit_fwd, dim3(grid), dim3(512), LDS_BYTES, stream, a); } }
#endif
    const hipError_t le = hipPeekAtLastError();
    if (le != hipSuccess) fprintf(stderr, "kernel_launch: launch failed: %s\n", hipGetErrorName(le));
}
```

```cpp
#include <hip/hip_runtime.h>
#include <cstdio>
#include <cstdint>

#ifndef MK_PER_STEP_LAUNCH
#define MK_PER_STEP_LAUNCH 0
#endif

#ifndef PROBE_REPEAT
#define PROBE_REPEAT 0
#endif
#define LAS __attribute__((address_space(3)))
#define GAS __attribute__((address_space(1)))
typedef _Float16 h16;
typedef _Float16 h16x8 __attribute__((ext_vector_type(8)));
typedef _Float16 h16x4 __attribute__((ext_vector_type(4)));
typedef _Float16 h16x2 __attribute__((ext_vector_type(2)));
typedef float f32x2 __attribute__((ext_vector_type(2)));
typedef float f32x4 __attribute__((ext_vector_type(4)));
typedef float f32x8 __attribute__((ext_vector_type(8)));
typedef float f32x16 __attribute__((ext_vector_type(16)));
typedef unsigned u32x2 __attribute__((ext_vector_type(2)));
typedef unsigned u32x4 __attribute__((ext_vector_type(4)));
typedef short s16x4 __attribute__((ext_vector_type(4)));

__device__ __forceinline__ unsigned pkh(float lo, float hi) { f32x2 v = {lo, hi}; h16x2 h = __builtin_convertvector(v, h16x2); return __builtin_bit_cast(unsigned, h); }

constexpr int DM = 1024, NTOK = 16384, NCTX = 8192, SEQC = 256, SEQL = 2048, NBL = 4, NBC = 32, PAST = 256, KVL = SEQL + PAST;
constexpr int DEPTH = 4, NH = 8, DFF = 2816, DFF2 = 5632;
constexpr int KROWS = NCTX + NBL * KVL;
constexpr float DN_ALPHA = 1.681792830507429f;
constexpr float LN_EPS = 1e-6f, SUBLN_EPS = 1e-5f;

constexpr size_t MiB = 1u << 20;
constexpr size_t WS_CTL = 0, CTL_ZERO_BYTES = 64 * 1024;
constexpr size_t WS_ADA = 1 * MiB;
constexpr size_t WS_ROPE = 1 * MiB + 512 * 1024;
constexpr size_t WS_HALO = 2 * MiB;
constexpr size_t WS_D256 = 4 * MiB;
constexpr size_t WS_D2048 = 5 * MiB;
constexpr size_t WS_WFT = 21 * MiB;
constexpr size_t WS_WPT = 25 * MiB;
constexpr size_t WS_WQKV = 33 * MiB;
constexpr size_t WS_WO = 39 * MiB;
constexpr size_t WS_WUP = 41 * MiB;
constexpr size_t WS_WDN = 52 * MiB;
constexpr size_t WS_H = 58 * MiB;
constexpr size_t WS_U0 = 90 * MiB;
constexpr size_t WS_U1 = 122 * MiB;
constexpr size_t WS_ARENA = 154 * MiB;
constexpr size_t WS_Q = WS_ARENA, WS_K = WS_ARENA + 32 * MiB, WS_V = WS_ARENA + 66 * MiB, WS_O = WS_ARENA + 100 * MiB;
constexpr size_t WS_XH = 330 * MiB;
constexpr size_t WS_ACT = WS_H;
constexpr size_t WS_UD = WS_ARENA;
constexpr size_t WS_END = 362 * MiB;
static_assert((size_t)KROWS * DM * 2 <= 34 * MiB, "K/V buffers");

constexpr int CW_BAR = 1024;

constexpr int RING_BYTES = 131072;
constexpr int LDSCTL_OFF = RING_BYTES, MISC_OFF = LDSCTL_OFF + 320;
constexpr int LDS_BYTES = 147456;

namespace pg8 {
constexpr int BM = 256, BK = 64, HALF = 128, HTB = HALF * BK * 2, STAGE_BYTES = 8 * HTB, NXCD = 8, WGM = 8;
__host__ __device__ __forceinline__ int lds_byte(int r, int c) { const int st = (r >> 4) * 2 + (c >> 5), rr = r & 15, cc = c & 31, ob = rr * 64 + cc * 2; return st * 1024 + (ob ^ (((ob >> 9) & 1) << 5)); }
__host__ __device__ __forceinline__ void stage_rc(int b, int& R, int& C) { const int st = b / 1024, sb = b % 1024, swz = sb ^ (((sb >> 9) & 1) << 5); R = (st >> 1) * 16 + swz / 64; C = (st & 1) * 32 + (swz % 64) / 2; }
__host__ __device__ __forceinline__ int perm32(int rho) { const int n = rho >> 4, i = rho & 15; return 8 * (i >> 2) + 4 * n + (i & 3); }

struct Unit { const char* a; const char* b; h16* o; int pm, pn; };

struct GSched {
    int nM, nN, nwg, total, G, c;
    int n0, n1;
    long as[3], bs[3], os[3];
    const char* A; const char* B; h16* O; long lda, ldb, ldc;
    __device__ __forceinline__ bool next(int i, Unit& u) const {
        const long L = (long)i * G + c; if (L >= total) return false;
        const int batch = (int)(L / nwg); int wgid = (int)(L % nwg);
        { const int q = nwg / NXCD, r = nwg % NXCD, xcd = wgid % NXCD, off = wgid / NXCD; wgid = (xcd < r ? xcd * (q + 1) : r * (q + 1) + (xcd - r) * q) + off; }
        const int nig = WGM * nN, gid = wgid / nig, fm = gid * WGM, gsz = (nM - fm) < WGM ? (nM - fm) : WGM;
        const int pm = fm + ((wgid % nig) % gsz), pn = (wgid % nig) / gsz;
        const int b0 = batch % n0, b1 = (batch / n0) % n1, b2 = batch / (n0 * n1);
        u.a = A + b0 * as[0] + b1 * as[1] + b2 * as[2] + (long)pm * BM * lda * 2;
        u.b = B + b0 * bs[0] + b1 * bs[1] + b2 * bs[2] + (long)pn * BM * ldb * 2;
        u.o = O + b0 * os[0] + b1 * os[1] + b2 * os[2] + (long)pm * BM * ldc + (long)pn * BM;
        u.pm = pm; u.pn = pn; return true;
    }
};

struct EpiStore16 {
    static constexpr bool PERM = true;
    long ldc; h16* halo;
    __device__ __forceinline__ void operator()(const f32x4 (&acc)[2][2][4][2], const Unit& u, int wr, int wc, int fr, int fq) const {
        asm volatile("" : "+v"(fr), "+v"(fq));
        const int col0 = wc * 32 + 8 * fq;
#pragma unroll
        for (int ai = 0; ai < 2; ++ai)
#pragma unroll
            for (int m = 0; m < 4; ++m) { const int r = ai * HALF + wr * 64 + m * 16 + fr; h16* rowp = u.o + (size_t)r * ldc + col0;
#pragma unroll
                for (int bj = 0; bj < 2; ++bj) { const f32x4 v0 = acc[ai][bj][m][0], v1 = acc[ai][bj][m][1];
                    u32x4 w; w.x = pkh(v0[0], v0[1]); w.y = pkh(v0[2], v0[3]); w.z = pkh(v1[0], v1[1]); w.w = pkh(v1[2], v1[3]);
                    *(u32x4*)(rowp + bj * HALF) = w;
                    if (halo && (r == 0 || r == 255)) *(u32x4*)(halo + ((size_t)u.pm * 2 + (r ? 1 : 0)) * ldc + (size_t)u.pn * BM + col0 + bj * HALF) = w; } }
    }
};

struct EpiQKV {
    static constexpr bool PERM = false;
    h16 *Q, *K, *V; float* nck; float* ncv; const float* rope; int j;
    __device__ __forceinline__ void operator()(const f32x4 (&acc)[2][2][4][2], const Unit& u, int wr, int wc, int fr, int fq) const {
        asm volatile("" : "+v"(fr), "+v"(fq));
        const int sect = u.pn >> 2, pnl = u.pn & 3; const bool lat = u.pm >= 32;
        const int bl = lat ? (u.pm - 32) >> 3 : 0, pml = lat ? (u.pm - 32) & 7 : 0;
        const long qrow0 = (long)u.pm * 256, krow0 = lat ? (long)NCTX + (long)bl * KVL + pml * 256 : (long)u.pm * 256;
        h16* dst = sect == 0 ? Q + qrow0 * DM : (sect == 1 ? K + krow0 * DM : V + krow0 * DM);
        const int colb = pnl * 256 + wc * 32 + 4 * fq;
        if (lat && sect < 2) {
            const int axis = wc & 1;
#pragma unroll
            for (int ai = 0; ai < 2; ++ai)
#pragma unroll
                for (int m = 0; m < 4; ++m) { const int r = ai * HALF + wr * 64 + m * 16 + fr;
                    const int pos = axis ? (m * 16 + fr) : (pml * 4 + ai * 2 + wr);
                    const f32x4 cs = *(const f32x4*)(rope + pos * 16 + 4 * fq), sn = *(const f32x4*)(rope + 1024 + pos * 16 + 4 * fq);
#pragma unroll
                    for (int bj = 0; bj < 2; ++bj) { const f32x4 x0 = acc[ai][bj][m][0], x1 = acc[ai][bj][m][1];
                        const f32x4 y0 = x0 * cs - x1 * sn, y1 = x1 * cs + x0 * sn;
                        h16* p = dst + (size_t)r * DM + colb + bj * HALF;
                        u32x2 w0, w1; w0.x = pkh(y0[0], y0[1]); w0.y = pkh(y0[2], y0[3]); w1.x = pkh(y1[0], y1[1]); w1.y = pkh(y1[2], y1[3]);
                        *(u32x2*)p = w0; *(u32x2*)(p + 16) = w1; }
                    asm volatile("" ::: "memory"); }
        } else {
            float* nc = (sect == 0 || lat) ? nullptr : (sect == 1 ? nck : ncv) + ((size_t)(u.pm * 2 + j) * 256) * DM;
#pragma unroll
            for (int ai = 0; ai < 2; ++ai)
#pragma unroll
                for (int m = 0; m < 4; ++m) { const int r = ai * HALF + wr * 64 + m * 16 + fr;
#pragma unroll
                    for (int bj = 0; bj < 2; ++bj) { const f32x4 y0 = acc[ai][bj][m][0], y1 = acc[ai][bj][m][1];
                        h16* p = dst + (size_t)r * DM + colb + bj * HALF;
                        u32x2 w0, w1; w0.x = pkh(y0[0], y0[1]); w0.y = pkh(y0[2], y0[3]); w1.x = pkh(y1[0], y1[1]); w1.y = pkh(y1[2], y1[3]);
                        *(u32x2*)p = w0; *(u32x2*)(p + 16) = w1;
                        if (nc) { float* q = nc + (size_t)r * DM + colb + bj * HALF; *(f32x4*)q = y0; *(f32x4*)(q + 16) = y1; } }
                    asm volatile("" ::: "memory"); }
        }
    }
};

template <class Epi, class Sched>
__device__ __forceinline__ void gemm_phase(LAS unsigned char* lds, const int tid, const int K, const long lda, const long ldb, const Sched& S, const Epi& E) {
    const int wid = __builtin_amdgcn_readfirstlane(tid >> 6), lane = tid & 63, wr = wid >> 2, wc = wid & 3, fr = lane & 15, fq = lane >> 4;
    const int nt = K / BK;
    unsigned voffA[2], voffB[2];
#pragma unroll
    for (int i = 0; i < 2; ++i) { int R, C; stage_rc(tid * 16 + i * 8192, R, C); const int Rb = Epi::PERM ? ((R & ~31) + perm32(R & 31)) : R;
        voffA[i] = (unsigned)((long)R * lda + C) * 2u; voffB[i] = (unsigned)((long)Rb * ldb + C) * 2u; }
    const size_t kstep = (size_t)(BK * 2);
    const size_t hstepA = (size_t)HALF * lda * 2, hstepB = (size_t)HALF * ldb * 2;
    const unsigned ldsw = (unsigned)wid * 1024u;
    const int aoff = lds_byte(wr * 64 + fr, fq * 8), boff = lds_byte(wc * 32 + fr, fq * 8);
#define PG8_SA(b, h) (((b) * 2 + (h)) * HTB)
#define PG8_SB(b, h) ((4 + (b) * 2 + (h)) * HTB)
#define PG8_STAGE(bufoff, gbase, voff) do { _Pragma("unroll") for (int _i = 0; _i < 2; ++_i) \
        __builtin_amdgcn_global_load_lds((const unsigned*)((const char*)(gbase) + (voff)[_i]), (LAS unsigned*)(lds + (bufoff) + ldsw + _i * 8192), 16, 0, 0); } while (0)
#define PG8_LDA(dst, b, h) do { _Pragma("unroll") for (int m = 0; m < 4; ++m) _Pragma("unroll") for (int k = 0; k < 2; ++k) dst[m][k] = *(const LAS h16x8*)(lds + PG8_SA(b, h) + aoff + m * 2048 + k * 1024); } while (0)
#define PG8_LDB(dst, b, h) do { _Pragma("unroll") for (int n = 0; n < 2; ++n) _Pragma("unroll") for (int k = 0; k < 2; ++k) dst[n][k] = *(const LAS h16x8*)(lds + PG8_SB(b, h) + boff + n * 2048 + k * 1024); } while (0)
#define PG8_MMA(ai, bj, At, Bt) do { __builtin_amdgcn_s_setprio(1); _Pragma("unroll") for (int m = 0; m < 4; ++m) _Pragma("unroll") for (int n = 0; n < 2; ++n) _Pragma("unroll") for (int k = 0; k < 2; ++k) \
        acc[ai][bj][m][n] = __builtin_amdgcn_mfma_f32_16x16x32_f16(Bt[n][k], At[m][k], acc[ai][bj][m][n], 0, 0, 0); __builtin_amdgcn_s_setprio(0); } while (0)
#define PG8_WAIT_V(n) asm volatile("s_waitcnt vmcnt(" #n ")" ::: "memory")
#define PG8_WAIT_L(n) asm volatile("s_waitcnt lgkmcnt(" #n ")" ::: "memory")
#define PG8_BAR __builtin_amdgcn_s_barrier()
#define PG8_SCHED __builtin_amdgcn_sched_barrier(0)
    Unit cur, nxt; int ui = 0;
    if (!S.next(0, cur)) return;
    f32x4 acc[2][2][4][2];
#pragma unroll
    for (int a = 0; a < 2; ++a)
#pragma unroll
        for (int b = 0; b < 2; ++b)
#pragma unroll
            for (int m = 0; m < 4; ++m)
#pragma unroll
                for (int n = 0; n < 2; ++n) acc[a][b][m][n] = (f32x4){0.f, 0.f, 0.f, 0.f};
    h16x8 At[4][2], B0[2][2], B1[2][2];
    const char* cA = cur.a; const char* cB = cur.b;
    PG8_STAGE(PG8_SB(0, 0), cB, voffB); PG8_STAGE(PG8_SB(0, 1), cB + hstepB, voffB); PG8_STAGE(PG8_SA(0, 0), cA, voffA); PG8_STAGE(PG8_SA(0, 1), cA + hstepA, voffA);
    if (wr == 1) PG8_BAR;
    PG8_WAIT_V(2); PG8_BAR;
    PG8_STAGE(PG8_SB(1, 0), cB + kstep, voffB); PG8_STAGE(PG8_SA(1, 0), cA + kstep, voffA); PG8_STAGE(PG8_SB(1, 1), cB + hstepB + kstep, voffB);
    PG8_WAIT_V(6); PG8_BAR;
    for (;;) {
        const bool has_next = S.next(ui + 1, nxt);
        const char* nA = has_next ? nxt.a : cA; const char* nB = has_next ? nxt.b : cB;
        for (int t = 0; t < nt; t += 2) {
            const bool last = (t == nt - 2);
            const char* a1 = cA + (size_t)(t + 1) * kstep;
            const char* a2 = last ? nA : cA + (size_t)(t + 2) * kstep; const char* b2 = last ? nB : cB + (size_t)(t + 2) * kstep;
            const char* a3 = a2 + kstep; const char* b3 = b2 + kstep;
            PG8_LDB(B0, 0, 0); PG8_LDB(B1, 0, 1); PG8_SCHED; PG8_LDA(At, 0, 0); PG8_STAGE(PG8_SA(1, 1), a1 + hstepA, voffA);
            PG8_WAIT_V(8); PG8_WAIT_L(0); PG8_BAR; PG8_MMA(0, 0, At, B0); PG8_MMA(0, 1, At, B1); PG8_BAR; PG8_SCHED;
            PG8_LDA(At, 0, 1); PG8_STAGE(PG8_SB(0, 0), b2, voffB); PG8_STAGE(PG8_SB(0, 1), b2 + hstepB, voffB); PG8_STAGE(PG8_SA(0, 0), a2, voffA);
            PG8_WAIT_V(8); PG8_WAIT_L(0); PG8_BAR; PG8_MMA(1, 0, At, B0); PG8_MMA(1, 1, At, B1); PG8_BAR; PG8_SCHED;
            PG8_LDB(B0, 1, 0); PG8_LDB(B1, 1, 1); PG8_SCHED; PG8_LDA(At, 1, 0); PG8_STAGE(PG8_SA(0, 1), a2 + hstepA, voffA);
            PG8_WAIT_V(8); PG8_WAIT_L(0); PG8_BAR; PG8_MMA(0, 0, At, B0); PG8_MMA(0, 1, At, B1); PG8_BAR; PG8_SCHED;
            PG8_LDA(At, 1, 1); PG8_STAGE(PG8_SB(1, 0), b3, voffB); PG8_STAGE(PG8_SB(1, 1), b3 + hstepB, voffB); PG8_STAGE(PG8_SA(1, 0), a3, voffA);
            PG8_WAIT_V(8); PG8_WAIT_L(0); PG8_BAR; PG8_MMA(1, 0, At, B0); PG8_MMA(1, 1, At, B1); PG8_BAR; PG8_SCHED;
        }
        if (wr == 0) PG8_BAR;
        E(acc, cur, wr, wc, fr, fq);
        if (!has_next) break;
#pragma unroll
        for (int a = 0; a < 2; ++a)
#pragma unroll
            for (int b = 0; b < 2; ++b)
#pragma unroll
                for (int m = 0; m < 4; ++m)
#pragma unroll
                    for (int n = 0; n < 2; ++n) acc[a][b][m][n] = (f32x4){0.f, 0.f, 0.f, 0.f};
        cur = nxt; cA = nA; cB = nB; ++ui;
        if (wr == 1) PG8_BAR;
    }
    PG8_WAIT_V(0);
    PG8_BAR;
#undef PG8_SA
#undef PG8_SB
#undef PG8_STAGE
#undef PG8_LDA
#undef PG8_LDB
#undef PG8_MMA
#undef PG8_WAIT_V
#undef PG8_WAIT_L
#undef PG8_BAR
#undef PG8_SCHED
}
}

namespace attn {
constexpr int D = 128, KVBLK = 64, QBLK = 32;
constexpr float SCALE = 0.125f;
constexpr float THR = 8.f;
constexpr size_t SHM_V = KVBLK * D * 2, SHM_K = KVBLK * D * 2, SHM_ATTN = 2 * SHM_V + 2 * SHM_K + 8 * 64 * 4;
#define KSWZ(row, colB) ((row) * 256 + ((colB) ^ (((row) & 7) << 4)))
#define SBAR() __builtin_amdgcn_sched_barrier(0)
__device__ __forceinline__ int crow(int r, int hi) { return (r & 3) + 8 * (r >> 2) + 4 * hi; }
__device__ __forceinline__ void partialSM(f32x16& p0, f32x16& p1, float& m_reg, float& mn, float& alpha) {
  constexpr float C = SCALE * 1.4426950408889634f;
  float pmax = p0[0];
#pragma unroll
  for (int r = 1; r < 16; ++r) pmax = fmaxf(pmax, p0[r]);
#pragma unroll
  for (int r = 0; r < 16; ++r) pmax = fmaxf(pmax, p1[r]);
  { auto rr = __builtin_amdgcn_permlane32_swap(__float_as_uint(pmax), __float_as_uint(pmax), false, false);
    pmax = fmaxf(__uint_as_float(rr[0]), __uint_as_float(rr[1])); }
  if (__builtin_expect(__all(pmax - m_reg <= THR / SCALE), 1)) { mn = m_reg; alpha = 1.f; }
  else { mn = fmaxf(m_reg, pmax); alpha = __builtin_amdgcn_exp2f((m_reg - mn) * C); m_reg = mn; }
  float mnC = -mn * C;
#pragma unroll
  for (int r = 0; r < 16; ++r) p0[r] = fmaf(p0[r], C, mnC);
#pragma unroll
  for (int r = 0; r < 16; ++r) p1[r] = fmaf(p1[r], C, mnC);
#pragma unroll
  for (int r = 0; r < 16; ++r) p0[r] = __builtin_amdgcn_exp2f(p0[r]);
}
__device__ __forceinline__ void finishSM(f32x16& p0, f32x16& p1, float alpha, float& l_reg, h16x8& pa0, h16x8& pa1, h16x8& pa2, h16x8& pa3) {
#pragma unroll
  for (int r = 0; r < 16; ++r) p1[r] = __builtin_amdgcn_exp2f(p1[r]);
  float ps = 0;
#pragma unroll
  for (int r = 0; r < 16; ++r) ps += p0[r];
#pragma unroll
  for (int r = 0; r < 16; ++r) ps += p1[r];
  { auto rr = __builtin_amdgcn_permlane32_swap(__float_as_uint(ps), __float_as_uint(ps), false, false);
    ps = __uint_as_float(rr[0]) + __uint_as_float(rr[1]); }
  l_reg = l_reg * alpha + ps;
#define PK4(P, BASE, OUT) do { unsigned a0 = pkh(P[BASE + 0], P[BASE + 1]), a1 = pkh(P[BASE + 2], P[BASE + 3]);   \
    unsigned b0 = pkh(P[BASE + 4], P[BASE + 5]), b1 = pkh(P[BASE + 6], P[BASE + 7]);                              \
    auto r0 = __builtin_amdgcn_permlane32_swap(a0, b0, false, false); auto r1 = __builtin_amdgcn_permlane32_swap(a1, b1, false, false); \
    u32x4 w = {r0[0], r1[0], r0[1], r1[1]}; OUT = __builtin_bit_cast(h16x8, w); } while (0)
  PK4(p0, 0, pa0); PK4(p0, 8, pa1); PK4(p1, 0, pa2); PK4(p1, 8, pa3);
#undef PK4
}
__device__ __forceinline__ void qkt(f32x16& p0, f32x16& p1, const char* Ks, const h16x8* qr, int r32, int hi, int t) {
  p0 = f32x16{}; p1 = f32x16{};
#pragma unroll
  for (int d0 = 0; d0 < 4; ++d0) { int cb = ((t * 4 + d0) * 16 + hi * 8) * 2;
    h16x8 b0 = *reinterpret_cast<const h16x8*>(Ks + KSWZ(r32, cb));
    h16x8 b1 = *reinterpret_cast<const h16x8*>(Ks + KSWZ(32 + r32, cb));
    p0 = __builtin_amdgcn_mfma_f32_32x32x16_f16(b0, qr[d0], p0, 0, 0, 0);
    p1 = __builtin_amdgcn_mfma_f32_32x32x16_f16(b1, qr[d0], p1, 0, 0, 0); }
}
__device__ __forceinline__ int v_st(int k, int c) { const int kk = (k & ~0xC) | ((k & 4) << 1) | ((k & 8) >> 1); return ((kk >> 3) * 4 + (c >> 5)) * 512 + ((kk & 7) * 32 + (c & 31)) * 2; }
__device__ __forceinline__ int v_rd_base(int lane) { return ((lane & 3) << 3) | (((lane >> 2) & 3) << 6) | (((lane >> 4) & 1) << 5) | (((lane >> 5) & 1) << 8); }
constexpr int v_rd_off(int d0, int ks, int half) { return d0 * 512 + ks * 4096 + half * 2048; }
template <int OFF> __device__ __forceinline__ s16x4 tr_read(int vb) {
  s16x4 r; asm volatile("ds_read_b64_tr_b16 %0, %1 offset:%2" : "=&v"(r) : "v"(vb), "i"(OFF) : "memory"); return r;
}
template <int D0> __device__ __forceinline__ void pv_one(f32x16& od, int vb, h16x8 pa0, h16x8 pa1, h16x8 pa2, h16x8 pa3) {
  const s16x4 l0 = tr_read<v_rd_off(D0, 0, 0)>(vb), h0 = tr_read<v_rd_off(D0, 0, 1)>(vb), l1 = tr_read<v_rd_off(D0, 1, 0)>(vb), h1 = tr_read<v_rd_off(D0, 1, 1)>(vb);
  const s16x4 l2 = tr_read<v_rd_off(D0, 2, 0)>(vb), h2 = tr_read<v_rd_off(D0, 2, 1)>(vb), l3 = tr_read<v_rd_off(D0, 3, 0)>(vb), h3 = tr_read<v_rd_off(D0, 3, 1)>(vb);
  asm volatile("s_waitcnt lgkmcnt(0)" ::: "memory"); SBAR();
#define PKV(L, H) __builtin_bit_cast(h16x8, (__attribute__((ext_vector_type(8))) short){L[0], L[1], L[2], L[3], H[0], H[1], H[2], H[3]})
  od = __builtin_amdgcn_mfma_f32_32x32x16_f16(pa0, PKV(l0, h0), od, 0, 0, 0);
  od = __builtin_amdgcn_mfma_f32_32x32x16_f16(pa1, PKV(l1, h1), od, 0, 0, 0);
  od = __builtin_amdgcn_mfma_f32_32x32x16_f16(pa2, PKV(l2, h2), od, 0, 0, 0);
  od = __builtin_amdgcn_mfma_f32_32x32x16_f16(pa3, PKV(l3, h3), od, 0, 0, 0);
#undef PKV
}
__device__ __forceinline__ void pv_d0(f32x16* o, int vb, h16x8 pa0, h16x8 pa1, h16x8 pa2, h16x8 pa3) {
  pv_one<0>(o[0], vb, pa0, pa1, pa2, pa3); pv_one<1>(o[1], vb, pa0, pa1, pa2, pa3); pv_one<2>(o[2], vb, pa0, pa1, pa2, pa3); pv_one<3>(o[3], vb, pa0, pa1, pa2, pa3);
}

__device__ __forceinline__ void unit(const int tid, const h16* __restrict__ Qb, const h16* __restrict__ Kh, const h16* __restrict__ Vh, h16* __restrict__ Ob, int seq, char* lds,
                                     float lam, float oml, const float* __restrict__ gsub) {
  constexpr int LDK = DM, LDQ = DM, LDO = DM;
  const int wid = tid >> 6, lane = tid & 63, r32 = lane & 31, hi = lane >> 5;
  const int qg = wid & 3, th = wid >> 2;
  char* V_lds = lds; char* K_lds = lds + 2 * SHM_V;
  float* ws = (float*)(lds + 2 * SHM_V + 2 * SHM_K) + wid * 64; float* li_l = ws; float* al_l = ws + 32;
  float m_reg = -1e30f, l_reg = 0; f32x16 o[4] = {}; h16x8 qr[4];
  const h16* Qw = Qb + (long)(qg * QBLK + r32) * LDQ + th * 64 + hi * 8;
#pragma unroll
  for (int d0 = 0; d0 < 4; ++d0) qr[d0] = *reinterpret_cast<const h16x8*>(Qw + d0 * 16);
  const int sr = tid >> 4, sc = (tid & 15) * 8, vst0 = v_st(sr, sc), vst1 = v_st(32 + sr, sc);
  const int vb0 = (int)(uintptr_t)V_lds + v_rd_base(lane);
  constexpr int SDEPTH = 1;
  struct { h16x8 vs0, vs1, ks0, ks1; } sr_[SDEPTH];
#define SLOAD(i, k0) do { sr_[i].vs0 = *reinterpret_cast<const h16x8*>(&Vh[(long)((k0) + sr) * LDK + sc]); sr_[i].vs1 = *reinterpret_cast<const h16x8*>(&Vh[(long)((k0) + 32 + sr) * LDK + sc]); \
    sr_[i].ks0 = *reinterpret_cast<const h16x8*>(&Kh[(long)((k0) + sr) * LDK + sc]); sr_[i].ks1 = *reinterpret_cast<const h16x8*>(&Kh[(long)((k0) + 32 + sr) * LDK + sc]); } while (0)
#define SWRITE(b, i) do { *(h16x8*)(V_lds + (b) * SHM_V + vst0) = sr_[i].vs0;          \
    *(h16x8*)(V_lds + (b) * SHM_V + vst1) = sr_[i].vs1; int kc = sc * 2;               \
    *(h16x8*)(K_lds + (b) * SHM_K + KSWZ(sr, kc)) = sr_[i].ks0;                       \
    *(h16x8*)(K_lds + (b) * SHM_K + KSWZ(32 + sr, kc)) = sr_[i].ks1; } while (0)
#define SWAIT() do { if constexpr (SDEPTH == 2) asm volatile("s_waitcnt vmcnt(4)" ::: "memory"); else asm volatile("s_waitcnt vmcnt(0)" ::: "memory"); } while (0)
#define RESC(a) do { if (__any((a) < 1.f)) { if (hi == 0) al_l[r32] = (a); asm volatile("s_waitcnt lgkmcnt(0)" ::: "memory"); \
    _Pragma("unroll") for (int d = 0; d < 4; ++d) _Pragma("unroll") for (int r = 0; r < 16; ++r) o[d][r] *= al_l[crow(r, hi)]; } } while (0)
  f32x16 pA0, pA1, pB0, pB1; float mnA, mnB, alA, alB; h16x8 pa0, pa1, pa2, pa3; const int NT = seq / KVBLK;
  constexpr int SE = 0, SO = SDEPTH - 1;
  SLOAD(SE, 0); asm volatile("s_waitcnt vmcnt(0)" ::: "memory"); SWRITE(0, SE); __syncthreads();
  qkt(pA0, pA1, K_lds, qr, r32, hi, th); partialSM(pA0, pA1, m_reg, mnA, alA);
  SLOAD(SO, KVBLK); if constexpr (SDEPTH == 2) { if (2 < NT) SLOAD(SE, 2 * KVBLK); }
  SWAIT(); SWRITE(1, SO); __syncthreads();
  for (int j = 1; j + 1 < NT; j += 2) {
    SBAR(); qkt(pB0, pB1, K_lds + SHM_K, qr, r32, hi, th);
    finishSM(pA0, pA1, alA, l_reg, pa0, pa1, pa2, pa3); SBAR();
    SLOAD(SO, (j + SDEPTH) * KVBLK); SBAR();
    pv_d0(o, vb0, pa0, pa1, pa2, pa3); partialSM(pB0, pB1, m_reg, mnB, alB);
    __syncthreads(); SWAIT(); SWRITE(0, SE);
    RESC(alB); __syncthreads();
    SBAR(); qkt(pA0, pA1, K_lds, qr, r32, hi, th);
    finishSM(pB0, pB1, alB, l_reg, pa0, pa1, pa2, pa3); SBAR();
    if (SDEPTH == 1 || j + 3 < NT) SLOAD(SE, (j + 1 + SDEPTH) * KVBLK); SBAR();
    pv_d0(o, vb0 + (int)SHM_V, pa0, pa1, pa2, pa3); partialSM(pA0, pA1, m_reg, mnA, alA);
    __syncthreads(); SWAIT(); SWRITE(1, SO);
    RESC(alA); __syncthreads();
  }
  SBAR(); qkt(pB0, pB1, K_lds + SHM_K, qr, r32, hi, th);
  finishSM(pA0, pA1, alA, l_reg, pa0, pa1, pa2, pa3); SBAR();
  pv_d0(o, vb0, pa0, pa1, pa2, pa3); partialSM(pB0, pB1, m_reg, mnB, alB);
  __syncthreads(); RESC(alB);
  finishSM(pB0, pB1, alB, l_reg, pa0, pa1, pa2, pa3); SBAR();
  pv_d0(o, vb0 + (int)SHM_V, pa0, pa1, pa2, pa3);
  if (hi == 0) li_l[r32] = l_reg; asm volatile("s_waitcnt lgkmcnt(0)" ::: "memory");
  float rli[16];
#pragma unroll
  for (int r = 0; r < 16; ++r) rli[r] = __builtin_amdgcn_rcpf(li_l[crow(r, hi)]);
  __syncthreads();
  float* X = (float*)lds + qg * 4096;
  if (th == 1) {
#pragma unroll
    for (int r = 0; r < 16; ++r)
#pragma unroll
      for (int d0 = 0; d0 < 4; ++d0) X[(r * 4 + d0) * 64 + lane] = o[d0][r] * rli[r] * (-lam);
  }
  __syncthreads();
  if (th == 0) {
    float gv[4];
#pragma unroll
    for (int d0 = 0; d0 < 4; ++d0) gv[d0] = gsub[d0 * 32 + r32] * oml;
    h16* Ow = Ob + (long)(qg * QBLK) * LDO;
#pragma unroll
    for (int r = 0; r < 16; ++r) {
      float v[4], ss = 0.f;
#pragma unroll
      for (int d0 = 0; d0 < 4; ++d0) { v[d0] = o[d0][r] * rli[r] + X[(r * 4 + d0) * 64 + lane]; ss += v[d0] * v[d0]; }
      ss += __shfl_xor(ss, 1); ss += __shfl_xor(ss, 2); ss += __shfl_xor(ss, 4); ss += __shfl_xor(ss, 8); ss += __shfl_xor(ss, 16);
      const float rs = rsqrtf(ss * (1.f / 128.f) + SUBLN_EPS);
      const int orow = crow(r, hi);
#pragma unroll
      for (int d0 = 0; d0 < 4; ++d0) Ow[(long)orow * LDO + d0 * 32 + r32] = (h16)(v[d0] * rs * gv[d0]);
    }
  }
  __syncthreads();
#undef SLOAD
#undef SWRITE
#undef SWAIT
#undef RESC
}
#undef SBAR
}

#define XB_TMO      128
#define XB_XCNT(j)  (256  + 64 * (j))
#define XB_XSUB(j)  (1280 + 64 * (j))
#define XB_XGEN(j)  (2304 + 64 * (j))
#define XB_TOP      3328
#define XB_TOPGEN   3392
#define XCD_BAR_WORDS 3456
#define XB_SPIN_CAP (1u << 20)
__device__ __forceinline__ unsigned xb_ld(unsigned* p)              { return __hip_atomic_load(p, __ATOMIC_RELAXED, __HIP_MEMORY_SCOPE_AGENT); }
__device__ __forceinline__ unsigned xb_add(unsigned* p, unsigned v) { return __hip_atomic_fetch_add(p, v, __ATOMIC_RELAXED, __HIP_MEMORY_SCOPE_AGENT); }
__device__ __forceinline__ unsigned xb_xcc_id() { return (unsigned)__builtin_amdgcn_s_getreg((3 << 11) | 20) & 0xFu; }
#define XB_SPIN(cond, bar) do { unsigned _sp = 0; while (cond) { __builtin_amdgcn_s_sleep(1); \
    if ((++_sp & 255u) == 0u) { if (xb_ld(&(bar)[XB_TMO])) break; if (_sp > XB_SPIN_CAP) { atomicAdd(&(bar)[XB_TMO], 1u); break; } } } } while (0)
struct XcdBarrier { unsigned* bar; unsigned x; volatile LAS unsigned* st; };
__device__ __forceinline__ XcdBarrier xcd_barrier_post(unsigned* bar, volatile LAS unsigned* st) {
    XcdBarrier b; b.bar = bar; b.x = xb_xcc_id(); b.st = st;
    if (threadIdx.x == 0) (void)xb_add(&bar[XB_XCNT(b.x)], 1u);
    return b;
}
__device__ __forceinline__ void xcd_barrier_complete(unsigned* bar, unsigned x, unsigned& nloc, unsigned& nx) {
    const unsigned G = gridDim.x * gridDim.y * gridDim.z;
    unsigned sum, cnt, mine, sp = 0u;
    for (;;) {
        sum = 0u; cnt = 0u; mine = 0u;
#pragma unroll
        for (unsigned j = 0; j < 16; ++j) { const unsigned c = xb_ld(&bar[XB_XCNT(j)]); sum += c; cnt += (c > 0u) ? 1u : 0u; mine = (j == x) ? c : mine; }
        if (sum == G) break;
        __builtin_amdgcn_s_sleep(1);
        if ((++sp & 255u) == 0u) { if (xb_ld(&bar[XB_TMO])) break; if (sp > XB_SPIN_CAP) { atomicAdd(&bar[XB_TMO], 1u); break; } }
    }
    nloc = mine > 0u ? mine : 1u; nx = cnt > 0u ? cnt : 1u;
}
__device__ __forceinline__ void xcd_barrier(const XcdBarrier& b) {
    asm volatile("s_waitcnt vmcnt(0)" ::: "memory");
    __syncthreads();
    if (threadIdx.x == 0) {
        unsigned* bar = b.bar;
        __builtin_amdgcn_s_waitcnt(0);
        unsigned nloc = b.st[0], nx = b.st[1];
        if (nloc == 0u) { xcd_barrier_complete(bar, b.x, nloc, nx); b.st[0] = nloc; b.st[1] = nx; }
        const unsigned old = xb_add(&bar[XB_XSUB(b.x)], 1u);
        const unsigned gen = old / nloc;
        if (old + 1u == (gen + 1u) * nloc) {
            __builtin_amdgcn_fence(__ATOMIC_RELEASE, "agent");
            asm volatile("s_waitcnt vmcnt(0)" ::: "memory");
            const unsigned og = xb_add(&bar[XB_TOP], 1u);
            const unsigned tg = og / nx;
            if (og + 1u == (tg + 1u) * nx) xb_add(&bar[XB_TOPGEN], 1u);
            else XB_SPIN(xb_ld(&bar[XB_TOPGEN]) == tg, bar);
            __builtin_amdgcn_fence(__ATOMIC_ACQUIRE, "agent");
            xb_add(&bar[XB_XGEN(b.x)], 1u);
            asm volatile("s_waitcnt vmcnt(0)" ::: "memory");
        } else {
            XB_SPIN(xb_ld(&bar[XB_XGEN(b.x)]) == gen, bar);
            __builtin_amdgcn_fence(__ATOMIC_ACQUIRE, "agent");
            asm volatile("s_waitcnt vmcnt(0)" ::: "memory");
        }
    }
    __syncthreads();
}

struct Args { const float* in[24]; float* out; unsigned char* ws; int s_lo, s_hi; };
enum { I_XP = 0, I_XS, I_CK, I_CV, I_C, I_CCTX, I_WADA, I_BADA, I_WF, I_WQKV, I_LQ1, I_LK1, I_LQ2, I_LK2, I_SUBG, I_WO, I_WUP, I_CONVW, I_CONVB, I_WDN, I_LN1G, I_LN1B, I_LN2G, I_LN2B };

struct Frame {
    LAS unsigned char* lds; char* ldsg;
    int tid, lane, wave, vcu, G;
};
__device__ __forceinline__ float wave_sum(float v) {
#pragma unroll
    for (int o = 1; o < 64; o <<= 1) v += __shfl_xor(v, o);
    return v;
}
__device__ __forceinline__ void transpose_item(const float* W, int K, int N, h16* WT, LAS float* scr, int item, int lane) {
    const int nblk = N / 32, kb = item / nblk, nb = item % nblk, k0 = 64 * kb, n0 = 32 * nb;
#pragma unroll 8
    for (int i = 0; i < 32; ++i) { const int kk = 2 * i + (lane >> 5); scr[kk * 33 + (lane & 31)] = W[(size_t)(k0 + kk) * N + n0 + (lane & 31)]; }
    asm volatile("s_waitcnt lgkmcnt(0)" ::: "memory");
    const int c = lane & 7;
#pragma unroll
    for (int j = 0; j < 4; ++j) { const int n = (lane >> 3) + 8 * j; const LAS float* s = scr + (8 * c) * 33 + n;
        u32x4 o; o.x = pkh(s[0 * 33], s[1 * 33]); o.y = pkh(s[2 * 33], s[3 * 33]); o.z = pkh(s[4 * 33], s[5 * 33]); o.w = pkh(s[6 * 33], s[7 * 33]);
        *(u32x4*)(WT + (size_t)(n0 + n) * K + k0 + 8 * c) = o; }
    asm volatile("s_waitcnt lgkmcnt(0)" ::: "memory");
}
__device__ __forceinline__ float silu_f(float x) { return x / (1.f + __expf(-x)); }

__device__ __forceinline__ void step_prep(const Frame& F, const Args& a, int L, bool first) {
    unsigned char* ws = a.ws;
    const int gw = F.vcu * 8 + F.wave, NGW = F.G * 8;
    if (first) {
        LAS float* S = (LAS float*)F.lds;
        LAS float* red = (LAS float*)(F.lds + 20480);
        if (F.vcu < 384) {
            for (int i = F.tid; i < 5 * 1024; i += 512) { const int cd = i >> 10, k = i & 1023; const float x = cd == 0 ? a.in[I_CCTX][k] : a.in[I_C][(cd - 1) * 1024 + k]; S[i] = silu_f(x); }
            __syncthreads();
            for (int it = F.vcu; it < 384; it += F.G) {
                const int Ly = it / 96, ch = it % 96; const int cq = F.lane & 15, kg = F.lane >> 4;
                const float* Wp = a.in[I_WADA] + (size_t)Ly * 1024 * 6144 + ch * 64 + cq * 4;
                f32x4 acc[5];
#pragma unroll
                for (int c = 0; c < 5; ++c) acc[c] = (f32x4){0.f, 0.f, 0.f, 0.f};
#pragma unroll 4
                for (int i = 0; i < 32; ++i) { const int k = F.wave * 128 + 4 * i + kg; const f32x4 w = *(const f32x4*)(Wp + (size_t)k * 6144);
#pragma unroll
                    for (int c = 0; c < 5; ++c) acc[c] += w * S[c * 1024 + k]; }
#pragma unroll
                for (int c = 0; c < 5; ++c)
#pragma unroll
                    for (int e = 0; e < 4; ++e) { float v = acc[c][e]; v += __shfl_xor(v, 16); v += __shfl_xor(v, 32); acc[c][e] = v; }
                if (kg == 0) {
#pragma unroll
                    for (int c = 0; c < 5; ++c)
#pragma unroll
                        for (int e = 0; e < 4; ++e) red[(F.wave * 5 + c) * 64 + cq * 4 + e] = acc[c][e]; }
                __syncthreads();
                if (F.tid < 320) { const int c = F.tid >> 6, col = F.tid & 63; float s = a.in[I_BADA][Ly * 6144 + ch * 64 + col];
#pragma unroll
                    for (int w = 0; w < 8; ++w) s += red[(w * 5 + c) * 64 + col];
                    ((float*)(ws + WS_ADA))[(Ly * 5 + c) * 6144 + ch * 64 + col] = s; }
                __syncthreads();
            }
        }
        if (F.vcu == 0) {
            float* rope = (float*)(ws + WS_ROPE);
            for (int i = F.tid; i < 1024; i += 512) { const int pos = i >> 4, f = i & 15; const float inv = exp2f(-(float)f * (13.287712379549449f / 16.f)); const float ang = (float)pos * inv;
                rope[i] = cosf(ang); rope[1024 + i] = sinf(ang); }
            if (F.tid < 2) { const int j = F.tid; float s1 = 0.f, s2 = 0.f;
                for (int d = 0; d < 64; ++d) { s1 += a.in[I_LQ1][j * 64 + d] * a.in[I_LK1][j * 64 + d]; s2 += a.in[I_LQ2][j * 64 + d] * a.in[I_LK2][j * 64 + d]; }
                const float li = 0.8f - 0.6f * expf(-0.3f * (float)(2 * j + 1));
                rope[2048 + j] = expf(s1) - expf(s2) + li; rope[2050 + j] = 1.f - li; }
        }
        {
            const int gt = F.vcu * 512 + F.tid, NGT = F.G * 512;
            h16* d256 = (h16*)(ws + WS_D256); h16* d2k = (h16*)(ws + WS_D2048);
            for (int it = gt; it < 3 * 256 * 32; it += NGT) { const int mat = it / (256 * 32), j = (it / 32) % 256, k0 = (it % 32) * 8; float v[8];
#pragma unroll
                for (int e = 0; e < 8; ++e) { const int m = (j * (k0 + e)) & 255; const float x = (float)m * (1.f / 128.f); v[e] = (mat == 0 ? cospif(x) : (mat == 1 ? -sinpif(x) : sinpif(x))) * 0.0625f; }
                u32x4 o = {pkh(v[0], v[1]), pkh(v[2], v[3]), pkh(v[4], v[5]), pkh(v[6], v[7])}; *(u32x4*)(d256 + (size_t)it * 8) = o; }
            for (int it = gt; it < 2 * 2048 * 256; it += NGT) { const int mat = it / (2048 * 256), j = (it / 256) % 2048, k0 = (it % 256) * 8; float v[8];
#pragma unroll
                for (int e = 0; e < 8; ++e) { const int m = (j * (k0 + e)) & 2047; const float x = (float)m * (1.f / 1024.f); v[e] = (mat == 0 ? cospif(x) : sinpif(x)) * 0.022097086912079608f; }
                u32x4 o = {pkh(v[0], v[1]), pkh(v[2], v[3]), pkh(v[4], v[5]), pkh(v[6], v[7])}; *(u32x4*)(d2k + (size_t)it * 8) = o; }
        }
        __syncthreads();
    }
    LAS float* scr = (LAS float*)(F.lds + F.wave * 16384);
    const bool att = (L & 1) != 0; const int j = L >> 1;
    const int I_UP = (1024 / 64) * (DFF2 / 32), I_DN = (DFF / 64) * (1024 / 32), I_QKV = att ? (1024 / 64) * (3072 / 32) : 0, I_O = att ? 512 : 0, I_F = first ? 1024 : 0, I_CR = att ? 2 * NBL * PAST : 0;
    const int NIT = I_UP + I_DN + I_QKV + I_O + I_F + I_CR;
    for (int it = gw; it < NIT; it += NGW) {
        int r = it;
        if (r < I_UP) { transpose_item(a.in[I_WUP] + (size_t)L * 1024 * DFF2, 1024, DFF2, (h16*)(ws + WS_WUP), scr, r, F.lane); continue; } r -= I_UP;
        if (r < I_DN) { transpose_item(a.in[I_WDN] + (size_t)L * DFF * 1024, DFF, 1024, (h16*)(ws + WS_WDN), scr, r, F.lane); continue; } r -= I_DN;
        if (r < I_QKV) { transpose_item(a.in[I_WQKV] + (size_t)j * 1024 * 3072, 1024, 3072, (h16*)(ws + WS_WQKV), scr, r, F.lane); continue; } r -= I_QKV;
        if (r < I_O) { transpose_item(a.in[I_WO] + (size_t)j * 1024 * 1024, 1024, 1024, (h16*)(ws + WS_WO), scr, r, F.lane); continue; } r -= I_O;
        if (r < I_F) { const int ly = r >> 9; transpose_item(a.in[I_WF] + (size_t)ly * 1024 * 1024, 1024, 1024, (h16*)(ws + WS_WFT) + (size_t)ly * 1024 * 1024, scr, r & 511, F.lane); continue; } r -= I_F;
        { const int kv = r / (NBL * PAST), rr = r % (NBL * PAST), b = rr / PAST, p = rr % PAST;
          const float* src = a.in[kv ? I_CV : I_CK] + ((size_t)(b * 2 + j) * PAST + p) * DM; h16* dst = (h16*)(ws + (kv ? WS_V : WS_K)) + ((size_t)NCTX + (size_t)b * KVL + SEQL + p) * DM;
#pragma unroll
          for (int q = 0; q < 4; ++q) { const f32x4 v = *(const f32x4*)(src + q * 256 + F.lane * 4); u32x2 o = {pkh(v[0], v[1]), pkh(v[2], v[3])}; *(u32x2*)(dst + q * 256 + F.lane * 4) = o; } }
    }
}

__device__ __forceinline__ f32x8 ld8f(const float* p) { return *(const f32x8*)p; }
__device__ __forceinline__ f32x8 ld8h(const h16* p) { const h16x8 v = *(const h16x8*)p; return __builtin_convertvector(v, f32x8); }
__device__ __forceinline__ void st8h(h16* p, const f32x8 v) { u32x4 o = {pkh(v[0], v[1]), pkh(v[2], v[3]), pkh(v[4], v[5]), pkh(v[6], v[7])}; *(u32x4*)p = o; }
__device__ __forceinline__ float sum8(const f32x8 v) { return ((v[0] + v[1]) + (v[2] + v[3])) + ((v[4] + v[5]) + (v[6] + v[7])); }
__device__ __forceinline__ void step_ln(const Frame& F, const Args& a, int mode, int L, bool two_u) {
    unsigned char* ws = a.ws;
    const int gw = F.vcu * 8 + F.wave, NGW = F.G * 8;
    const float* ada = (const float*)(ws + WS_ADA);
    const h16* U0 = (const h16*)(ws + (mode == 2 ? WS_UD : WS_U0)); const h16* U1 = (const h16*)(ws + WS_U1); h16* H = (h16*)(ws + WS_H); h16* XH = (h16*)(ws + WS_XH);
    const bool from_in = (mode == 0) || (mode == 1 && L == 0);
    const bool last = (mode == 2 && L == DEPTH - 1);
    const bool has_h = !last;
    const int Lh = (mode == 2) ? L + 1 : L;
    const int jsh = (mode == 1) ? 3 : 0, jsc = jsh + 1, jg = (mode == 1) ? 2 : 5;
    const float* lng = a.in[mode == 1 ? I_LN1G : I_LN2G] + L * DM; const float* lnb = a.in[mode == 1 ? I_LN1B : I_LN2B] + L * DM;
    for (int chunk = gw; chunk < NTOK / 8; chunk += NGW) {
        const int row0 = chunk * 8; const int cond = row0 < NCTX ? 0 : 1 + ((row0 - NCTX) >> 11);
        f32x8 gate[2], vg[2], vb[2], vsc[2], vsh[2];
#pragma unroll
        for (int q = 0; q < 2; ++q) { const int c = q * 512 + F.lane * 8;
            if (mode != 0) { gate[q] = ld8f(ada + (size_t)(L * 5 + cond) * 6144 + jg * 1024 + c); vg[q] = ld8f(lng + c); vb[q] = ld8f(lnb + c); }
            if (has_h) { vsc[q] = ld8f(ada + (size_t)(Lh * 5 + cond) * 6144 + jsc * 1024 + c) + 1.f; vsh[q] = ld8f(ada + (size_t)(Lh * 5 + cond) * 6144 + jsh * 1024 + c); } }
#pragma unroll 2
        for (int rr = 0; rr < 8; ++rr) {
            const int row = row0 + rr; const size_t ro = (size_t)row * DM + F.lane * 8;
            f32x8 v[2];
            if (from_in) { const float* xr = (row < NCTX ? a.in[I_XP] : a.in[I_XS] - (size_t)NCTX * DM) + ro; v[0] = ld8f(xr); v[1] = ld8f(xr + 512); }
            else { v[0] = ld8h(XH + ro); v[1] = ld8h(XH + ro + 512); }
            if (mode != 0) {
                float s = 0.f;
#pragma unroll
                for (int q = 0; q < 2; ++q) { f32x8 uf = ld8h(U0 + ro + q * 512); if (two_u) uf += ld8h(U1 + ro + q * 512);
                    v[q] = v[q] * DN_ALPHA + gate[q] * uf; s += sum8(v[q]); }
                const float mean = wave_sum(s) * (1.f / DM); float s2 = 0.f;
#pragma unroll
                for (int q = 0; q < 2; ++q) { v[q] = v[q] - mean; s2 += sum8(v[q] * v[q]); }
                const float rstd = rsqrtf(wave_sum(s2) * (1.f / DM) + LN_EPS);
#pragma unroll
                for (int q = 0; q < 2; ++q) { v[q] = v[q] * rstd * vg[q] + vb[q];
                    if (last) { *(f32x8*)(a.out + ro + q * 512) = v[q]; } else st8h(XH + ro + q * 512, v[q]); }
            }
            if (has_h) {
                const float mean = wave_sum(sum8(v[0]) + sum8(v[1])) * (1.f / DM); float s2 = 0.f;
#pragma unroll
                for (int q = 0; q < 2; ++q) { v[q] = v[q] - mean; s2 += sum8(v[q] * v[q]); }
                const float rstd = rsqrtf(wave_sum(s2) * (1.f / DM) + LN_EPS);
#pragma unroll
                for (int q = 0; q < 2; ++q) st8h(H + ro + q * 512, v[q] * rstd * vsc[q] + vsh[q]);
            }
        }
    }
}

__device__ __forceinline__ void step_convgate(const Frame& F, const Args& a, int L) {
    unsigned char* ws = a.ws;
    const int gw = F.vcu * 8 + F.wave, NGW = F.G * 8;
    const h16* UU = (const h16*)(ws + WS_ARENA); h16* ACT = (h16*)(ws + WS_ACT);
    const float* cw = a.in[I_CONVW] + (size_t)L * 3 * DFF2; const float* cb = a.in[I_CONVB] + (size_t)L * DFF2;
    const int rg = F.lane >> 4, cl = F.lane & 15;
    for (int it = gw; it < 512 * 22; it += NGW) {
        const int rb = it / 22, cg = it % 22; const int col = cg * 128 + cl * 8;
        const int r0 = rb * 32 + rg * 8;
        const int seqlen_m1 = r0 < NCTX ? SEQC - 1 : SEQL - 1; const int t0 = (r0 < NCTX ? r0 : r0 - NCTX) & seqlen_m1;
        const bool zp = (t0 == 0), zn = (t0 + 8 > seqlen_m1);
        h16x8 u[2][10];
        const h16x8 zero = {0, 0, 0, 0, 0, 0, 0, 0};
#pragma unroll
        for (int p = 0; p < 2; ++p) {
            const h16* b = UU + (size_t)r0 * DFF2 + p * DFF + col;
            u[p][0] = zp ? zero : *(const h16x8*)(b - DFF2);
#pragma unroll
            for (int i = 0; i < 8; ++i) u[p][1 + i] = *(const h16x8*)(b + (size_t)i * DFF2);
            u[p][9] = zn ? zero : *(const h16x8*)(b + (size_t)8 * DFF2);
        }
        float w[2][3][8], bb[2][8];
#pragma unroll
        for (int p = 0; p < 2; ++p) {
#pragma unroll
            for (int d = 0; d < 3; ++d) { const f32x8 x = ld8f(cw + d * DFF2 + p * DFF + col);
#pragma unroll
                for (int e = 0; e < 8; ++e) w[p][d][e] = x[e]; }
            const f32x8 y = ld8f(cb + p * DFF + col);
#pragma unroll
            for (int e = 0; e < 8; ++e) bb[p][e] = y[e]; }
#pragma unroll
        for (int i = 0; i < 8; ++i) {
            float av[8];
#pragma unroll
            for (int e = 0; e < 8; ++e) {
                const float x = w[0][0][e] * (float)u[0][i][e] + w[0][1][e] * (float)u[0][i + 1][e] + w[0][2][e] * (float)u[0][i + 2][e] + bb[0][e];
                const float g = w[1][0][e] * (float)u[1][i][e] + w[1][1][e] * (float)u[1][i + 1][e] + w[1][2][e] * (float)u[1][i + 2][e] + bb[1][e];
                av[e] = x * __builtin_amdgcn_rcpf(1.f + __expf(-x)) * g; }
            u32x4 o = {pkh(av[0], av[1]), pkh(av[2], av[3]), pkh(av[4], av[5]), pkh(av[6], av[7])};
            *(u32x4*)(ACT + (size_t)(r0 + i) * DFF + col) = o;
        }
    }
}

__device__ __forceinline__ void step_attn(const Frame& F, const Args& a, int L) {
    unsigned char* ws = a.ws; const int j = L >> 1;
    const h16* Q = (const h16*)(ws + WS_Q); const h16* K = (const h16*)(ws + WS_K); const h16* V = (const h16*)(ws + WS_V); h16* O = (h16*)(ws + WS_O);
    const float* lamp = (const float*)(ws + WS_ROPE) + 2048; const float lam = lamp[j], oml = lamp[2 + j];
    const float* gsub = a.in[I_SUBG] + j * 128;
    for (int it = F.vcu; it < 1024; it += F.G) {
        int kind, id;
        if (F.G == 256) { kind = (it >> 8) & 1; id = ((it >> 9) << 8) + (it & 255); }
        else { kind = it >= 512; id = it & 511; }
        size_t qrow, krow; int h, seq;
        if (kind == 0) { const int bh = id >> 4, qb = id & 15, b = bh >> 3; h = bh & 7; qrow = (size_t)NCTX + (size_t)b * SEQL + qb * 128; krow = (size_t)NCTX + (size_t)b * KVL; seq = KVL; }
        else { const int bh = id >> 1, qb = id & 1, b = bh >> 3; h = bh & 7; qrow = (size_t)b * SEQC + qb * 128; krow = (size_t)b * SEQC; seq = SEQC; }
        attn::unit(F.tid, Q + qrow * DM + h * 128, K + krow * DM + h * 128, V + krow * DM + h * 128, O + qrow * DM + h * 128, seq, F.ldsg, lam, oml, gsub);
    }
}

enum { K_PREP0 = 0, K_GEMM, K_QKV, K_LN, K_CG, K_ATT };
enum { GV_WP = 0, GV_FA, GV_FBL, GV_FBC, GV_O, GV_UP, GV_DN };
constexpr int NSTEPS = 3 + 8 * DEPTH;

__global__ void __launch_bounds__(512, 2) dit_fwd(Args args) {
    extern __shared__ __attribute__((aligned(16))) unsigned char lds_raw[];
    unsigned char* ws = args.ws;
    volatile LAS unsigned* MISC = (volatile LAS unsigned*)((LAS unsigned char*)lds_raw + MISC_OFF);
    for (int u = threadIdx.x; u < (LDS_BYTES - LDSCTL_OFF) / 4; u += 512) ((LAS unsigned*)((LAS unsigned char*)lds_raw + LDSCTL_OFF))[u] = 0u;
    __syncthreads();
#if !MK_PER_STEP_LAUNCH
    XcdBarrier bar = xcd_barrier_post((unsigned*)(ws + WS_CTL) + CW_BAR, MISC + 8);
#endif
    for (int ss = 2 * args.s_lo; ss < 2 * args.s_hi; ++ss) {
        const int s = ss >> 1, rep = ss & 1;
        Frame F;
        { int t_ = threadIdx.x; asm volatile("" : "+v"(t_)); F.tid = t_; }
        F.lds = (LAS unsigned char*)lds_raw; F.ldsg = (char*)lds_raw;
        F.lane = F.tid & 63; F.wave = __builtin_amdgcn_readfirstlane(F.tid >> 6);
        F.G = gridDim.x; { const int bx = blockIdx.x; F.vcu = (F.G % 8 == 0) ? (bx % 8) * (F.G / 8) + bx / 8 : bx; }
        int kind, L = 0, var = 0, mode = 0; bool sync_after = true, two_u = false;
        if (s == 0) kind = K_PREP0;
        else if (s == 1) { kind = K_GEMM; var = GV_WP; sync_after = false; }
        else if (s == 2) { kind = K_LN; mode = 0; }
        else { const int q = s - 3; L = q >> 3; const int jj = q & 7; const bool att = (L & 1) != 0;
            switch (jj) {
                case 0: if (att) kind = K_QKV; else { kind = K_GEMM; var = GV_FA; } break;
                case 1: if (att) kind = K_ATT; else { kind = K_GEMM; var = GV_FBL; sync_after = false; } break;
                case 2: kind = K_GEMM; var = att ? GV_O : GV_FBC; break;
                case 3: kind = K_LN; mode = 1; two_u = !att; break;
                case 4: kind = K_GEMM; var = GV_UP; break;
                case 5: kind = K_CG; break;
                case 6: kind = K_GEMM; var = GV_DN; break;
                default: kind = K_LN; mode = 2; break;
            }
        }
        { const int bit = kind == K_GEMM ? 1 : kind == K_QKV ? 2 : kind == K_ATT ? 4 : kind == K_PREP0 ? 8 : 0; if (rep == 0 && !(PROBE_REPEAT & bit)) continue; }
        if (kind == K_PREP0) { step_prep(F, args, 0, true); }
        else if (kind == K_GEMM) {
            pg8::GSched S; S.G = F.G; S.c = (int)blockIdx.x; S.n0 = 1; S.n1 = 1;
            for (int i = 0; i < 3; ++i) { S.as[i] = 0; S.bs[i] = 0; S.os[i] = 0; }
            int K = 1024; h16* halo = nullptr;
            if (var == GV_WP) { S.nM = 4; S.nN = 1; S.n0 = 4; S.n1 = 2; S.A = (const char*)(ws + WS_WFT); S.B = (const char*)(ws + WS_D256); S.O = (h16*)(ws + WS_WPT);
                S.lda = 1024; S.ldb = 256; S.ldc = 1024; K = 256;
                S.as[0] = 256 * 2; S.bs[0] = 0; S.os[0] = 256;
                S.as[1] = 0; S.bs[1] = 256 * 256 * 2; S.os[1] = 1024 * 1024;
                S.as[2] = 1024 * 1024 * 2; S.bs[2] = 0; S.os[2] = 2048 * 1024;
                S.total = 4 * 1 * 4 * 2 * 2; }
            else if (var == GV_FA) { S.nM = 8; S.nN = 64; S.A = (const char*)(ws + WS_WPT) + (size_t)(L >> 1) * 2048 * 1024 * 2; S.B = (const char*)(ws + WS_H); S.O = (h16*)(ws + WS_ARENA);
                S.lda = 1024; S.ldb = 1024; S.ldc = NTOK; K = 1024; S.total = 512; }
            else if (var == GV_FBL) { S.nM = 8; S.nN = 4; S.n0 = 4; S.n1 = 2; S.A = (const char*)(ws + WS_D2048); S.B = (const char*)(ws + WS_ARENA) + (size_t)NCTX * 2; S.O = (h16*)(ws + WS_U0) + (size_t)NCTX * DM;
                S.lda = 2048; S.ldb = NTOK; S.ldc = DM; K = 2048;
                S.as[0] = 0; S.bs[0] = 2048 * 2; S.os[0] = 2048 * DM;
                S.as[1] = 2048L * 2048 * 2; S.bs[1] = 1024L * NTOK * 2; S.os[1] = (long)NTOK * DM;
                S.total = 32 * 8; }
            else if (var == GV_FBC) { S.nM = 1; S.nN = 4; S.n0 = 32; S.n1 = 2; S.A = (const char*)(ws + WS_D256); S.B = (const char*)(ws + WS_ARENA); S.O = (h16*)(ws + WS_U0);
                S.lda = 256; S.ldb = NTOK; S.ldc = DM; K = 256;
                S.as[0] = 0; S.bs[0] = 256 * 2; S.os[0] = 256 * DM;
                S.as[1] = 2 * 256 * 256 * 2; S.bs[1] = 1024L * NTOK * 2; S.os[1] = (long)NTOK * DM;
                S.total = 4 * 64; }
            else if (var == GV_O) { S.nM = 64; S.nN = 4; S.A = (const char*)(ws + WS_O); S.B = (const char*)(ws + WS_WO); S.O = (h16*)(ws + WS_U0); S.lda = 1024; S.ldb = 1024; S.ldc = DM; K = 1024; S.total = 256; }
            else if (var == GV_UP) { S.nM = 64; S.nN = 22; S.A = (const char*)(ws + WS_H); S.B = (const char*)(ws + WS_WUP); S.O = (h16*)(ws + WS_ARENA); S.lda = 1024; S.ldb = 1024; S.ldc = DFF2; K = 1024; S.total = 64 * 22;
                }
            else { S.nM = 64; S.nN = 4; S.A = (const char*)(ws + WS_ACT); S.B = (const char*)(ws + WS_WDN); S.O = (h16*)(ws + WS_UD); S.lda = DFF; S.ldb = DFF; S.ldc = DM; K = DFF; S.total = 256; }
            S.nwg = S.nM * S.nN;
            pg8::EpiStore16 E{S.ldc, halo};
            pg8::gemm_phase<pg8::EpiStore16, pg8::GSched>(F.lds, F.tid, K, S.lda, S.ldb, S, E);
        }
        else if (kind == K_QKV) {
            pg8::GSched S; S.G = F.G; S.c = (int)blockIdx.x; S.n0 = 1; S.n1 = 1;
            for (int i = 0; i < 3; ++i) { S.as[i] = 0; S.bs[i] = 0; S.os[i] = 0; }
            S.nM = 64; S.nN = 12; S.nwg = 768; S.total = 768; S.A = (const char*)(ws + WS_H); S.B = (const char*)(ws + WS_WQKV); S.O = nullptr; S.lda = 1024; S.ldb = 1024; S.ldc = DM;
            pg8::EpiQKV E{(h16*)(ws + WS_Q), (h16*)(ws + WS_K), (h16*)(ws + WS_V), args.out + 16777216, args.out + 33554432, (const float*)(ws + WS_ROPE), L >> 1};
            pg8::gemm_phase<pg8::EpiQKV, pg8::GSched>(F.lds, F.tid, 1024, 1024, 1024, S, E);
        }
        else if (kind == K_LN) {
            step_ln(F, args, mode, L, two_u);
            if (mode == 2 && L + 1 < DEPTH) step_prep(F, args, L + 1, false);
        }
        else if (kind == K_CG) { step_convgate(F, args, L); }
        else { step_attn(F, args, L); }
#if !MK_PER_STEP_LAUNCH
        if (rep == 1 && sync_after && s + 1 < args.s_hi) { xcd_barrier(bar); if (PROBE_REPEAT & 16) xcd_barrier(bar); }
        else __syncthreads();
#else
        (void)sync_after; __syncthreads();
#endif
    }
}

extern "C" void kernel_launch(void* const* d_in, const int* in_sizes, int n_in, void* d_out, int out_size, void* d_ws, size_t ws_size, hipStream_t stream) {
    static int grid = 0;
    if (grid == 0) {
        if (n_in != 24 || out_size != 50331648 || ws_size < WS_END) { fprintf(stderr, "kernel_launch: unexpected shapes: n_in %d out %d ws %zu (need %zu)\n", n_in, out_size, ws_size, (size_t)WS_END); grid = -1; return; }
        int dev = 0, cus = 0, per_cu = 0;
        if (hipGetDevice(&dev) != hipSuccess || hipDeviceGetAttribute(&cus, hipDeviceAttributeMultiprocessorCount, dev) != hipSuccess) { grid = -1; return; }
        if (hipFuncSetAttribute((const void*)dit_fwd, hipFuncAttributeMaxDynamicSharedMemorySize, LDS_BYTES) != hipSuccess) { fprintf(stderr, "kernel_launch: hipFuncSetAttribute failed\n"); grid = -1; return; }
        if (hipOccupancyMaxActiveBlocksPerMultiprocessor(&per_cu, (const void*)dit_fwd, 512, LDS_BYTES) != hipSuccess || per_cu < 1) { fprintf(stderr, "kernel_launch: occupancy query says %d\n", per_cu); per_cu = 1; }
        (void)hipGetLastError();
        grid = cus * (per_cu < 1 ? per_cu : 1);
    }
    if (grid < 0) return;
    (void)hipMemsetAsync((char*)d_ws + WS_CTL, 0, CTL_ZERO_BYTES, stream);
    Args a{};
    for (int i = 0; i < 24; ++i) a.in[i] = (const float*)d_in[i];
    a.out = (float*)d_out; a.ws = (unsigned char*)d_ws;
#if MK_PER_STEP_LAUNCH
    for (int s = 0; s < NSTEPS; ++s) { a.s_lo = s; a.s_hi = s + 1; hipLaunchKernelGGL(dit_fwd, dim3(grid), dim3(512), LDS_BYTES, stream, a); }
#else
    a.s_lo = 0; a.s_hi = NSTEPS;
    { void* kargs[] = {&a};
      if (hipLaunchCooperativeKernel((const void*)dit_fwd, dim3(grid), dim3(512), kargs, LDS_BYTES, stream) != hipSuccess) {
          (void)hipGetLastError(); hipLaunchKernelGGL(dit_fwd, dim3(grid), dim3(512), LDS_BYTES, stream, a); } }
#endif
    const hipError_t le = hipPeekAtLastError();
    if (le != hipSuccess) fprintf(stderr, "kernel_launch: launch failed: %s\n", hipGetErrorName(le));
}
```

```cpp
#include <hip/hip_runtime.h>
#include <cstdio>
#include <cstdint>

#ifndef MK_PER_STEP_LAUNCH
#define MK_PER_STEP_LAUNCH 0
#endif

#ifndef PROBE_REPEAT
#define PROBE_REPEAT 0
#endif
#define LAS __attribute__((address_space(3)))
#define GAS __attribute__((address_space(1)))
typedef _Float16 h16;
typedef _Float16 h16x8 __attribute__((ext_vector_type(8)));
typedef _Float16 h16x4 __attribute__((ext_vector_type(4)));
typedef _Float16 h16x2 __attribute__((ext_vector_type(2)));
typedef float f32x2 __attribute__((ext_vector_type(2)));
typedef float f32x4 __attribute__((ext_vector_type(4)));
typedef float f32x8 __attribute__((ext_vector_type(8)));
typedef float f32x16 __attribute__((ext_vector_type(16)));
typedef unsigned u32x2 __attribute__((ext_vector_type(2)));
typedef unsigned u32x4 __attribute__((ext_vector_type(4)));
typedef short s16x4 __attribute__((ext_vector_type(4)));

__device__ __forceinline__ unsigned pkh(float lo, float hi) { f32x2 v = {lo, hi}; h16x2 h = __builtin_convertvector(v, h16x2); return __builtin_bit_cast(unsigned, h); }

constexpr int DM = 1024, NTOK = 16384, NCTX = 8192, SEQC = 256, SEQL = 2048, NBL = 4, NBC = 32, PAST = 256, KVL = SEQL + PAST;
constexpr int DEPTH = 4, NH = 8, DFF = 2816, DFF2 = 5632;
constexpr int KROWS = NCTX + NBL * KVL;
constexpr float DN_ALPHA = 1.681792830507429f;
constexpr float LN_EPS = 1e-6f, SUBLN_EPS = 1e-5f;

constexpr size_t MiB = 1u << 20;
constexpr size_t WS_CTL = 0, CTL_ZERO_BYTES = 64 * 1024;
constexpr size_t WS_ADA = 1 * MiB;
constexpr size_t WS_ROPE = 1 * MiB + 512 * 1024;
constexpr size_t WS_HALO = 2 * MiB;
constexpr size_t WS_D256 = 4 * MiB;
constexpr size_t WS_D2048 = 5 * MiB;
constexpr size_t WS_WFT = 21 * MiB;
constexpr size_t WS_WPT = 25 * MiB;
constexpr size_t WS_WQKV = 33 * MiB;
constexpr size_t WS_WO = 39 * MiB;
constexpr size_t WS_WUP = 41 * MiB;
constexpr size_t WS_WDN = 52 * MiB;
constexpr size_t WS_H = 58 * MiB;
constexpr size_t WS_U0 = 90 * MiB;
constexpr size_t WS_U1 = 122 * MiB;
constexpr size_t WS_ARENA = 154 * MiB;
constexpr size_t WS_Q = WS_ARENA, WS_K = WS_ARENA + 32 * MiB, WS_V = WS_ARENA + 66 * MiB, WS_O = WS_ARENA + 100 * MiB;
constexpr size_t WS_XH = 330 * MiB;
constexpr size_t WS_ACT = WS_ARENA;
constexpr size_t WS_UD = WS_U0;
constexpr size_t WS_END = 362 * MiB;
static_assert((size_t)KROWS * DM * 2 <= 34 * MiB, "K/V buffers");

constexpr int CW_BAR = 1024;

constexpr int RING_BYTES = 131072;
constexpr int LDSCTL_OFF = RING_BYTES, MISC_OFF = LDSCTL_OFF + 320;
constexpr int XCH_OFF = LDSCTL_OFF + 1024;
constexpr int LDS_BYTES = 147456;

namespace pg8 {
constexpr int BM = 256, BK = 64, HALF = 128, HTB = HALF * BK * 2, STAGE_BYTES = 8 * HTB, NXCD = 8, WGM = 8;
__host__ __device__ __forceinline__ int lds_byte(int r, int c) { const int st = (r >> 4) * 2 + (c >> 5), rr = r & 15, cc = c & 31, ob = rr * 64 + cc * 2; return st * 1024 + (ob ^ (((ob >> 9) & 1) << 5)); }
__host__ __device__ __forceinline__ void stage_rc(int b, int& R, int& C) { const int st = b / 1024, sb = b % 1024, swz = sb ^ (((sb >> 9) & 1) << 5); R = (st >> 1) * 16 + swz / 64; C = (st & 1) * 32 + (swz % 64) / 2; }
__host__ __device__ __forceinline__ int perm32(int rho) { const int n = rho >> 4, i = rho & 15; return 8 * (i >> 2) + 4 * n + (i & 3); }

struct Unit { const char* a; const char* b; h16* o; int pm, pn; };

__device__ __forceinline__ int up_t0(int pm) { return pm < 32 ? 256 * pm : NCTX + 2048 * ((pm - 32) / 9) + 254 * ((pm - 32) % 9) - 1; }
struct GSched {
    int nM, nN, nwg, total, G, c;
    int n0, n1;
    int upmode;
    long as[3], bs[3], os[3];
    const char* A; const char* B; h16* O; long lda, ldb, ldc;
    __device__ __forceinline__ bool next(int i, Unit& u) const {
        const long L = (long)i * G + c; if (L >= total) return false;
        const int batch = (int)(L / nwg); int wgid = (int)(L % nwg);
        { const int q = nwg / NXCD, r = nwg % NXCD, xcd = wgid % NXCD, off = wgid / NXCD; wgid = (xcd < r ? xcd * (q + 1) : r * (q + 1) + (xcd - r) * q) + off; }
        const int nig = WGM * nN, gid = wgid / nig, fm = gid * WGM, gsz = (nM - fm) < WGM ? (nM - fm) : WGM;
        const int pm = fm + ((wgid % nig) % gsz), pn = (wgid % nig) / gsz;
        const int b0 = batch % n0, b1 = (batch / n0) % n1, b2 = batch / (n0 * n1);
        u.a = A + b0 * as[0] + b1 * as[1] + b2 * as[2] + (upmode ? (long)up_t0(pm) : (long)pm * BM) * lda * 2;
        u.b = B + b0 * bs[0] + b1 * bs[1] + b2 * bs[2] + (long)pn * BM * ldb * 2;
        u.o = O + b0 * os[0] + b1 * os[1] + b2 * os[2] + (long)pm * BM * ldc + (long)pn * BM;
        u.pm = pm; u.pn = pn; return true;
    }
};

struct EpiStore16 {
    static constexpr bool PERM = true, APERM = false;
    long ldc; h16* halo;
    __device__ __forceinline__ void operator()(f32x4 (&acc)[2][2][4][2], const Unit& u, int wr, int wc, int fr, int fq, LAS float* xl) const {
        asm volatile("" : "+v"(fr), "+v"(fq));
        const int col0 = wc * 32 + 8 * fq;
#pragma unroll
        for (int ai = 0; ai < 2; ++ai)
#pragma unroll
            for (int m = 0; m < 4; ++m) { const int r = ai * HALF + wr * 64 + m * 16 + fr; h16* rowp = u.o + (size_t)r * ldc + col0;
#pragma unroll
                for (int bj = 0; bj < 2; ++bj) { const f32x4 v0 = acc[ai][bj][m][0], v1 = acc[ai][bj][m][1];
                    u32x4 w; w.x = pkh(v0[0], v0[1]); w.y = pkh(v0[2], v0[3]); w.z = pkh(v1[0], v1[1]); w.w = pkh(v1[2], v1[3]);
                    *(u32x4*)(rowp + bj * HALF) = w;
                    if (halo && (r == 0 || r == 255)) *(u32x4*)(halo + ((size_t)u.pm * 2 + (r ? 1 : 0)) * ldc + (size_t)u.pn * BM + col0 + bj * HALF) = w; } }
    }
};

struct EpiQKV {
    static constexpr bool PERM = false, APERM = false;
    h16 *Q, *K, *V; float* nck; float* ncv; const float* rope; int j;
    __device__ __forceinline__ void operator()(f32x4 (&acc)[2][2][4][2], const Unit& u, int wr, int wc, int fr, int fq, LAS float* xl) const {
        asm volatile("" : "+v"(fr), "+v"(fq));
        const int sect = u.pn >> 2, pnl = u.pn & 3; const bool lat = u.pm >= 32;
        const int bl = lat ? (u.pm - 32) >> 3 : 0, pml = lat ? (u.pm - 32) & 7 : 0;
        const long qrow0 = (long)u.pm * 256, krow0 = lat ? (long)NCTX + (long)bl * KVL + pml * 256 : (long)u.pm * 256;
        h16* dst = sect == 0 ? Q + qrow0 * DM : (sect == 1 ? K + krow0 * DM : V + krow0 * DM);
        const int colb = pnl * 256 + wc * 32 + 4 * fq;
        if (lat && sect < 2) {
            const int axis = wc & 1;
#pragma unroll
            for (int ai = 0; ai < 2; ++ai)
#pragma unroll
                for (int m = 0; m < 4; ++m) { const int r = ai * HALF + wr * 64 + m * 16 + fr;
                    const int pos = axis ? (m * 16 + fr) : (pml * 4 + ai * 2 + wr);
                    const f32x4 cs = *(const f32x4*)(rope + pos * 16 + 4 * fq), sn = *(const f32x4*)(rope + 1024 + pos * 16 + 4 * fq);
#pragma unroll
                    for (int bj = 0; bj < 2; ++bj) { const f32x4 x0 = acc[ai][bj][m][0], x1 = acc[ai][bj][m][1];
                        const f32x4 y0 = x0 * cs - x1 * sn, y1 = x1 * cs + x0 * sn;
                        h16* p = dst + (size_t)r * DM + colb + bj * HALF;
                        u32x2 w0, w1; w0.x = pkh(y0[0], y0[1]); w0.y = pkh(y0[2], y0[3]); w1.x = pkh(y1[0], y1[1]); w1.y = pkh(y1[2], y1[3]);
                        *(u32x2*)p = w0; *(u32x2*)(p + 16) = w1; }
                    asm volatile("" ::: "memory"); }
        } else {
            float* nc = (sect == 0 || lat) ? nullptr : (sect == 1 ? nck : ncv) + ((size_t)(u.pm * 2 + j) * 256) * DM;
#pragma unroll
            for (int ai = 0; ai < 2; ++ai)
#pragma unroll
                for (int m = 0; m < 4; ++m) { const int r = ai * HALF + wr * 64 + m * 16 + fr;
#pragma unroll
                    for (int bj = 0; bj < 2; ++bj) { const f32x4 y0 = acc[ai][bj][m][0], y1 = acc[ai][bj][m][1];
                        h16* p = dst + (size_t)r * DM + colb + bj * HALF;
                        u32x2 w0, w1; w0.x = pkh(y0[0], y0[1]); w0.y = pkh(y0[2], y0[3]); w1.x = pkh(y1[0], y1[1]); w1.y = pkh(y1[2], y1[3]);
                        *(u32x2*)p = w0; *(u32x2*)(p + 16) = w1;
                        if (nc) { float* q = nc + (size_t)r * DM + colb + bj * HALF; *(f32x4*)q = y0; *(f32x4*)(q + 16) = y1; } }
                    asm volatile("" ::: "memory"); }
        }
    }
};


template <int CTRL> __device__ __forceinline__ float dpp1(float x) { return __builtin_bit_cast(float, __builtin_amdgcn_update_dpp(0, __builtin_bit_cast(int, x), CTRL, 0xf, 0xf, false)); }
template <int CTRL> __device__ __forceinline__ f32x4 dpp4(const f32x4 v) {
    f32x4 r; r.x = dpp1<CTRL>(v.x); r.y = dpp1<CTRL>(v.y); r.z = dpp1<CTRL>(v.z); r.w = dpp1<CTRL>(v.w); return r; }
struct EpiConvGate {
    static constexpr bool PERM = true, APERM = true;
    h16* ACT; const float* cw; const float* cb;
    __device__ __forceinline__ void operator()(f32x4 (&acc)[2][2][4][2], const Unit& u, int wr, int wc, int fr, int fq, LAS float* xl) const {
        asm volatile("" : "+v"(fr), "+v"(fq));
        const int pm = u.pm; const bool lat = pm >= 32; const int kt = lat ? (pm - 32) % 9 : 0;
        const int T0 = up_t0(pm); const int q = wr * 16 + fr;
        if (lat && kt == 0) { if (q == 0) {
#pragma unroll
            for (int bj = 0; bj < 2; ++bj)
#pragma unroll
                for (int n = 0; n < 2; ++n) acc[0][bj][0][n] = (f32x4){0.f, 0.f, 0.f, 0.f}; } }
        if (lat && kt == 8) {
#pragma unroll
            for (int j = 0; j < 8; ++j) if (8 * q + j >= 17) {
#pragma unroll
                for (int bj = 0; bj < 2; ++bj)
#pragma unroll
                    for (int n = 0; n < 2; ++n) acc[j >> 2][bj][j & 3][n] = (f32x4){0.f, 0.f, 0.f, 0.f}; } }
        LAS float* xw = xl + ((wc * 2) * 4 + fq) * 16;
        if (wr == 0 && fr == 15) {
#pragma unroll
            for (int bj = 0; bj < 2; ++bj)
#pragma unroll
                for (int n = 0; n < 2; ++n) *(LAS f32x4*)(xw + (bj * 2 + n) * 4) = acc[1][bj][3][n]; }
        if (wr == 1 && fr == 0) {
#pragma unroll
            for (int bj = 0; bj < 2; ++bj)
#pragma unroll
                for (int n = 0; n < 2; ++n) *(LAS f32x4*)(xw + 64 + (bj * 2 + n) * 4) = acc[0][bj][0][n]; }
        asm volatile("s_waitcnt lgkmcnt(0)" ::: "memory"); __builtin_amdgcn_s_barrier(); asm volatile("" ::: "memory");
        const int colb = u.pn * 128 + wc * 32 + 8 * fq;
#pragma unroll
        for (int bj = 0; bj < 2; ++bj)
#pragma unroll
            for (int n = 0; n < 2; ++n) {
                const float* wp = cw + bj * DFF + colb + 4 * n;
                const f32x4 w0 = *(const f32x4*)wp, w1 = *(const f32x4*)(wp + DFF2), w2 = *(const f32x4*)(wp + 2 * DFF2), bb = *(const f32x4*)(cb + bj * DFF + colb + 4 * n);
                f32x4 prv = dpp4<0x111>(acc[1][bj][3][n]), p8 = dpp4<0x101>(acc[0][bj][0][n]);
                if (wr == 1 && fr == 0) prv = *(LAS f32x4*)(xw + (bj * 2 + n) * 4);
                if (wr == 0 && fr == 15) p8 = *(LAS f32x4*)(xw + 64 + (bj * 2 + n) * 4);
#pragma unroll
                for (int j = 0; j < 8; ++j) {
                    const f32x4 cur = acc[j >> 2][bj][j & 3][n];
                    const f32x4 nxt = (j < 7) ? acc[(j + 1) >> 2][bj][(j + 1) & 3][n] : p8;
                    acc[j >> 2][bj][j & 3][n] = w0 * prv + (w1 * cur + (w2 * nxt + bb));
                    prv = cur; }
            }
        h16* orow = ACT + (size_t)(T0 + 8 * q) * DFF + colb;
#pragma unroll
        for (int j = 0; j < 8; ++j) {
            const int t = 8 * q + j;
            const bool valid = !lat || (t >= 1 && t <= 254 && (kt < 8 || t <= 16));
            unsigned pk[4];
#pragma unroll
            for (int n = 0; n < 2; ++n) { const f32x4 av = acc[j >> 2][0][j & 3][n], gv = acc[j >> 2][1][j & 3][n]; f32x4 o;
#pragma unroll
                for (int e = 0; e < 4; ++e) o[e] = av[e] * __builtin_amdgcn_rcpf(1.f + __expf(-av[e])) * gv[e];
                pk[2 * n] = pkh(o[0], o[1]); pk[2 * n + 1] = pkh(o[2], o[3]); }
            if (valid) { u32x4 w = {pk[0], pk[1], pk[2], pk[3]}; *(u32x4*)(orow + (size_t)j * DFF) = w; }
        }
    }
};

template <class Epi, class Sched>
__device__ __forceinline__ void gemm_phase(LAS unsigned char* lds, const int tid, const int K, const long lda, const long ldb, const Sched& S, const Epi& E) {
    const int wid = __builtin_amdgcn_readfirstlane(tid >> 6), lane = tid & 63, wr = wid >> 2, wc = wid & 3, fr = lane & 15, fq = lane >> 4;
    const int nt = K / BK;
    unsigned voffA, voffB;
    { int R, C; stage_rc(tid * 16, R, C); const int Rb = Epi::PERM ? ((R & ~31) + perm32(R & 31)) : R;
        const int Ra = Epi::APERM ? (128 * (R >> 6) + 8 * (R & 15) + ((R >> 4) & 3)) : R;
        voffA = (unsigned)((long)Ra * lda + C) * 2u; voffB = (unsigned)((long)Rb * ldb + C) * 2u; }
    const size_t dltA = (size_t)(Epi::APERM ? 128 : 64) * lda * 2, dltB = (size_t)64 * ldb * 2;
    const size_t kstep = (size_t)(BK * 2);
    const size_t hstepA = (size_t)(Epi::APERM ? 4 : HALF) * lda * 2, hstepB = (size_t)HALF * ldb * 2;
    const unsigned ldsw = (unsigned)wid * 1024u;
    const int aoff = lds_byte(wr * 64 + fr, fq * 8), boff = lds_byte(wc * 32 + fr, fq * 8);
#define PG8_SA(b, h) (((b) * 2 + (h)) * HTB)
#define PG8_SB(b, h) ((4 + (b) * 2 + (h)) * HTB)
#define PG8_STAGE(bufoff, gbase, voff) do { \
        __builtin_amdgcn_global_load_lds((const unsigned*)((const char*)(gbase) + (voff)), (LAS unsigned*)(lds + (bufoff) + ldsw), 16, 0, 0); \
        __builtin_amdgcn_global_load_lds((const unsigned*)((const char*)(gbase) + dlt_##voff + (voff)), (LAS unsigned*)(lds + (bufoff) + ldsw + 8192), 16, 0, 0); } while (0)
#define dlt_voffA dltA
#define dlt_voffB dltB
#define PG8_LDA(dst, b, h) do { _Pragma("unroll") for (int m = 0; m < 4; ++m) _Pragma("unroll") for (int k = 0; k < 2; ++k) dst[m][k] = *(const LAS h16x8*)(lds + PG8_SA(b, h) + aoff + m * 2048 + k * 1024); } while (0)
#define PG8_LDB(dst, b, h) do { _Pragma("unroll") for (int n = 0; n < 2; ++n) _Pragma("unroll") for (int k = 0; k < 2; ++k) dst[n][k] = *(const LAS h16x8*)(lds + PG8_SB(b, h) + boff + n * 2048 + k * 1024); } while (0)
#define PG8_MMA(ai, bj, At, Bt) do { __builtin_amdgcn_s_setprio(1); _Pragma("unroll") for (int m = 0; m < 4; ++m) _Pragma("unroll") for (int n = 0; n < 2; ++n) _Pragma("unroll") for (int k = 0; k < 2; ++k) \
        acc[ai][bj][m][n] = __builtin_amdgcn_mfma_f32_16x16x32_f16(Bt[n][k], At[m][k], acc[ai][bj][m][n], 0, 0, 0); __builtin_amdgcn_s_setprio(0); } while (0)
#define PG8_WAIT_V(n) asm volatile("s_waitcnt vmcnt(" #n ")" ::: "memory")
#define PG8_WAIT_L(n) asm volatile("s_waitcnt lgkmcnt(" #n ")" ::: "memory")
#define PG8_BAR __builtin_amdgcn_s_barrier()
#define PG8_SCHED __builtin_amdgcn_sched_barrier(0)
    Unit cur, nxt; int ui = 0;
    if (!S.next(0, cur)) return;
    f32x4 acc[2][2][4][2];
#pragma unroll
    for (int a = 0; a < 2; ++a)
#pragma unroll
        for (int b = 0; b < 2; ++b)
#pragma unroll
            for (int m = 0; m < 4; ++m)
#pragma unroll
                for (int n = 0; n < 2; ++n) acc[a][b][m][n] = (f32x4){0.f, 0.f, 0.f, 0.f};
    h16x8 At[4][2], B0[2][2], B1[2][2];
    const char* cA = cur.a; const char* cB = cur.b;
    PG8_STAGE(PG8_SB(0, 0), cB, voffB); PG8_STAGE(PG8_SB(0, 1), cB + hstepB, voffB); PG8_STAGE(PG8_SA(0, 0), cA, voffA); PG8_STAGE(PG8_SA(0, 1), cA + hstepA, voffA);
    if (wr == 1) PG8_BAR;
    PG8_WAIT_V(2); PG8_BAR;
    PG8_STAGE(PG8_SB(1, 0), cB + kstep, voffB); PG8_STAGE(PG8_SA(1, 0), cA + kstep, voffA); PG8_STAGE(PG8_SB(1, 1), cB + hstepB + kstep, voffB);
    PG8_WAIT_V(6); PG8_BAR;
    for (;;) {
        const bool has_next = S.next(ui + 1, nxt);
        const char* nA = has_next ? nxt.a : cA; const char* nB = has_next ? nxt.b : cB;
        for (int t = 0; t < nt; t += 2) {
            const bool last = (t == nt - 2);
            const char* a1 = cA + (size_t)(t + 1) * kstep;
            const char* a2 = last ? nA : cA + (size_t)(t + 2) * kstep; const char* b2 = last ? nB : cB + (size_t)(t + 2) * kstep;
            const char* a3 = a2 + kstep; const char* b3 = b2 + kstep;
            PG8_LDB(B0, 0, 0); PG8_LDB(B1, 0, 1); PG8_SCHED; PG8_LDA(At, 0, 0); PG8_STAGE(PG8_SA(1, 1), a1 + hstepA, voffA);
            PG8_WAIT_V(8); PG8_WAIT_L(0); PG8_BAR; PG8_MMA(0, 0, At, B0); PG8_MMA(0, 1, At, B1); PG8_BAR; PG8_SCHED;
            PG8_LDA(At, 0, 1); PG8_STAGE(PG8_SB(0, 0), b2, voffB); PG8_STAGE(PG8_SB(0, 1), b2 + hstepB, voffB); PG8_STAGE(PG8_SA(0, 0), a2, voffA);
            PG8_WAIT_V(8); PG8_WAIT_L(0); PG8_BAR; PG8_MMA(1, 0, At, B0); PG8_MMA(1, 1, At, B1); PG8_BAR; PG8_SCHED;
            PG8_LDB(B0, 1, 0); PG8_LDB(B1, 1, 1); PG8_SCHED; PG8_LDA(At, 1, 0); PG8_STAGE(PG8_SA(0, 1), a2 + hstepA, voffA);
            PG8_WAIT_V(8); PG8_WAIT_L(0); PG8_BAR; PG8_MMA(0, 0, At, B0); PG8_MMA(0, 1, At, B1); PG8_BAR; PG8_SCHED;
            PG8_LDA(At, 1, 1); PG8_STAGE(PG8_SB(1, 0), b3, voffB); PG8_STAGE(PG8_SB(1, 1), b3 + hstepB, voffB); PG8_STAGE(PG8_SA(1, 0), a3, voffA);
            PG8_WAIT_V(8); PG8_WAIT_L(0); PG8_BAR; PG8_MMA(1, 0, At, B0); PG8_MMA(1, 1, At, B1); PG8_BAR; PG8_SCHED;
        }
        if (wr == 0) PG8_BAR;
        E(acc, cur, wr, wc, fr, fq, (LAS float*)(lds + XCH_OFF));
        if (!has_next) break;
#pragma unroll
        for (int a = 0; a < 2; ++a)
#pragma unroll
            for (int b = 0; b < 2; ++b)
#pragma unroll
                for (int m = 0; m < 4; ++m)
#pragma unroll
                    for (int n = 0; n < 2; ++n) acc[a][b][m][n] = (f32x4){0.f, 0.f, 0.f, 0.f};
        cur = nxt; cA = nA; cB = nB; ++ui;
        if (wr == 1) PG8_BAR;
    }
    PG8_WAIT_V(0);
    PG8_BAR;
#undef PG8_SA
#undef PG8_SB
#undef PG8_STAGE
#undef dlt_voffA
#undef dlt_voffB
#undef PG8_LDA
#undef PG8_LDB
#undef PG8_MMA
#undef PG8_WAIT_V
#undef PG8_WAIT_L
#undef PG8_BAR
#undef PG8_SCHED
}
}

namespace attn {
constexpr int D = 128, KVBLK = 64, QBLK = 32;
constexpr float SCALE = 0.125f;
constexpr float THR = 8.f;
constexpr size_t SHM_V = KVBLK * D * 2, SHM_K = KVBLK * D * 2, SHM_ATTN = 2 * SHM_V + 2 * SHM_K + 8 * 64 * 4;
#define KSWZ(row, colB) ((row) * 256 + ((colB) ^ (((row) & 7) << 4)))
#define SBAR() __builtin_amdgcn_sched_barrier(0)
__device__ __forceinline__ int crow(int r, int hi) { return (r & 3) + 8 * (r >> 2) + 4 * hi; }
__device__ __forceinline__ void partialSM(f32x16& p0, f32x16& p1, float& m_reg, float& mn, float& alpha) {
  constexpr float C = SCALE * 1.4426950408889634f;
  float pmax = p0[0];
#pragma unroll
  for (int r = 1; r < 16; ++r) pmax = fmaxf(pmax, p0[r]);
#pragma unroll
  for (int r = 0; r < 16; ++r) pmax = fmaxf(pmax, p1[r]);
  { auto rr = __builtin_amdgcn_permlane32_swap(__float_as_uint(pmax), __float_as_uint(pmax), false, false);
    pmax = fmaxf(__uint_as_float(rr[0]), __uint_as_float(rr[1])); }
  if (__builtin_expect(__all(pmax - m_reg <= THR / SCALE), 1)) { mn = m_reg; alpha = 1.f; }
  else { mn = fmaxf(m_reg, pmax); alpha = __builtin_amdgcn_exp2f((m_reg - mn) * C); m_reg = mn; }
  float mnC = -mn * C;
#pragma unroll
  for (int r = 0; r < 16; ++r) p0[r] = fmaf(p0[r], C, mnC);
#pragma unroll
  for (int r = 0; r < 16; ++r) p1[r] = fmaf(p1[r], C, mnC);
#pragma unroll
  for (int r = 0; r < 16; ++r) p0[r] = __builtin_amdgcn_exp2f(p0[r]);
}
__device__ __forceinline__ void finishSM(f32x16& p0, f32x16& p1, float alpha, float& l_reg, h16x8& pa0, h16x8& pa1, h16x8& pa2, h16x8& pa3) {
#pragma unroll
  for (int r = 0; r < 16; ++r) p1[r] = __builtin_amdgcn_exp2f(p1[r]);
  float ps = 0;
#pragma unroll
  for (int r = 0; r < 16; ++r) ps += p0[r];
#pragma unroll
  for (int r = 0; r < 16; ++r) ps += p1[r];
  { auto rr = __builtin_amdgcn_permlane32_swap(__float_as_uint(ps), __float_as_uint(ps), false, false);
    ps = __uint_as_float(rr[0]) + __uint_as_float(rr[1]); }
  l_reg = l_reg * alpha + ps;
#define PK4(P, BASE, OUT) do { unsigned a0 = pkh(P[BASE + 0], P[BASE + 1]), a1 = pkh(P[BASE + 2], P[BASE + 3]);   \
    unsigned b0 = pkh(P[BASE + 4], P[BASE + 5]), b1 = pkh(P[BASE + 6], P[BASE + 7]);                              \
    auto r0 = __builtin_amdgcn_permlane32_swap(a0, b0, false, false); auto r1 = __builtin_amdgcn_permlane32_swap(a1, b1, false, false); \
    u32x4 w = {r0[0], r1[0], r0[1], r1[1]}; OUT = __builtin_bit_cast(h16x8, w); } while (0)
  PK4(p0, 0, pa0); PK4(p0, 8, pa1); PK4(p1, 0, pa2); PK4(p1, 8, pa3);
#undef PK4
}
__device__ __forceinline__ void qkt(f32x16& p0, f32x16& p1, const char* Ks, const h16x8* qr, int r32, int hi, int t) {
  p0 = f32x16{}; p1 = f32x16{};
#pragma unroll
  for (int d0 = 0; d0 < 4; ++d0) { int cb = ((t * 4 + d0) * 16 + hi * 8) * 2;
    h16x8 b0 = *reinterpret_cast<const h16x8*>(Ks + KSWZ(r32, cb));
    h16x8 b1 = *reinterpret_cast<const h16x8*>(Ks + KSWZ(32 + r32, cb));
    p0 = __builtin_amdgcn_mfma_f32_32x32x16_f16(b0, qr[d0], p0, 0, 0, 0);
    p1 = __builtin_amdgcn_mfma_f32_32x32x16_f16(b1, qr[d0], p1, 0, 0, 0); }
}
__device__ __forceinline__ int v_st(int k, int c) { const int kk = (k & ~0xC) | ((k & 4) << 1) | ((k & 8) >> 1); return ((kk >> 3) * 4 + (c >> 5)) * 512 + ((kk & 7) * 32 + (c & 31)) * 2; }
__device__ __forceinline__ int v_rd_base(int lane) { return ((lane & 3) << 3) | (((lane >> 2) & 3) << 6) | (((lane >> 4) & 1) << 5) | (((lane >> 5) & 1) << 8); }
constexpr int v_rd_off(int d0, int ks, int half) { return d0 * 512 + ks * 4096 + half * 2048; }
template <int OFF> __device__ __forceinline__ s16x4 tr_read(int vb) {
  s16x4 r; asm volatile("ds_read_b64_tr_b16 %0, %1 offset:%2" : "=&v"(r) : "v"(vb), "i"(OFF) : "memory"); return r;
}
template <int D0> __device__ __forceinline__ void pv_one(f32x16& od, int vb, h16x8 pa0, h16x8 pa1, h16x8 pa2, h16x8 pa3) {
  const s16x4 l0 = tr_read<v_rd_off(D0, 0, 0)>(vb), h0 = tr_read<v_rd_off(D0, 0, 1)>(vb), l1 = tr_read<v_rd_off(D0, 1, 0)>(vb), h1 = tr_read<v_rd_off(D0, 1, 1)>(vb);
  const s16x4 l2 = tr_read<v_rd_off(D0, 2, 0)>(vb), h2 = tr_read<v_rd_off(D0, 2, 1)>(vb), l3 = tr_read<v_rd_off(D0, 3, 0)>(vb), h3 = tr_read<v_rd_off(D0, 3, 1)>(vb);
  asm volatile("s_waitcnt lgkmcnt(0)" ::: "memory"); SBAR();
#define PKV(L, H) __builtin_bit_cast(h16x8, (__attribute__((ext_vector_type(8))) short){L[0], L[1], L[2], L[3], H[0], H[1], H[2], H[3]})
  od = __builtin_amdgcn_mfma_f32_32x32x16_f16(pa0, PKV(l0, h0), od, 0, 0, 0);
  od = __builtin_amdgcn_mfma_f32_32x32x16_f16(pa1, PKV(l1, h1), od, 0, 0, 0);
  od = __builtin_amdgcn_mfma_f32_32x32x16_f16(pa2, PKV(l2, h2), od, 0, 0, 0);
  od = __builtin_amdgcn_mfma_f32_32x32x16_f16(pa3, PKV(l3, h3), od, 0, 0, 0);
#undef PKV
}
__device__ __forceinline__ void pv_d0(f32x16* o, int vb, h16x8 pa0, h16x8 pa1, h16x8 pa2, h16x8 pa3) {
  pv_one<0>(o[0], vb, pa0, pa1, pa2, pa3); pv_one<1>(o[1], vb, pa0, pa1, pa2, pa3); pv_one<2>(o[2], vb, pa0, pa1, pa2, pa3); pv_one<3>(o[3], vb, pa0, pa1, pa2, pa3);
}

__device__ __forceinline__ void unit(const int tid, const h16* __restrict__ Qb, const h16* __restrict__ Kh, const h16* __restrict__ Vh, h16* __restrict__ Ob, int seq, char* lds,
                                     float lam, float oml, const float* __restrict__ gsub) {
  constexpr int LDK = DM, LDQ = DM, LDO = DM;
  const int wid = tid >> 6, lane = tid & 63, r32 = lane & 31, hi = lane >> 5;
  const int qg = wid & 3, th = wid >> 2;
  char* V_lds = lds; char* K_lds = lds + 2 * SHM_V;
  float* ws = (float*)(lds + 2 * SHM_V + 2 * SHM_K) + wid * 64; float* li_l = ws; float* al_l = ws + 32;
  float m_reg = -1e30f, l_reg = 0; f32x16 o[4] = {}; h16x8 qr[4];
  const h16* Qw = Qb + (long)(qg * QBLK + r32) * LDQ + th * 64 + hi * 8;
#pragma unroll
  for (int d0 = 0; d0 < 4; ++d0) qr[d0] = *reinterpret_cast<const h16x8*>(Qw + d0 * 16);
  const int sr = tid >> 4, sc = (tid & 15) * 8, vst0 = v_st(sr, sc), vst1 = v_st(32 + sr, sc);
  const int vb0 = (int)(uintptr_t)V_lds + v_rd_base(lane);
  constexpr int SDEPTH = 1;
  struct { h16x8 vs0, vs1, ks0, ks1; } sr_[SDEPTH];
#define SLOAD(i, k0) do { sr_[i].vs0 = *reinterpret_cast<const h16x8*>(&Vh[(long)((k0) + sr) * LDK + sc]); sr_[i].vs1 = *reinterpret_cast<const h16x8*>(&Vh[(long)((k0) + 32 + sr) * LDK + sc]); \
    sr_[i].ks0 = *reinterpret_cast<const h16x8*>(&Kh[(long)((k0) + sr) * LDK + sc]); sr_[i].ks1 = *reinterpret_cast<const h16x8*>(&Kh[(long)((k0) + 32 + sr) * LDK + sc]); } while (0)
#define SWRITE(b, i) do { *(h16x8*)(V_lds + (b) * SHM_V + vst0) = sr_[i].vs0;          \
    *(h16x8*)(V_lds + (b) * SHM_V + vst1) = sr_[i].vs1; int kc = sc * 2;               \
    *(h16x8*)(K_lds + (b) * SHM_K + KSWZ(sr, kc)) = sr_[i].ks0;                       \
    *(h16x8*)(K_lds + (b) * SHM_K + KSWZ(32 + sr, kc)) = sr_[i].ks1; } while (0)
#define SWAIT() do { if constexpr (SDEPTH == 2) asm volatile("s_waitcnt vmcnt(4)" ::: "memory"); else asm volatile("s_waitcnt vmcnt(0)" ::: "memory"); } while (0)
#define RESC(a) do { if (__any((a) < 1.f)) { if (hi == 0) al_l[r32] = (a); asm volatile("s_waitcnt lgkmcnt(0)" ::: "memory"); \
    _Pragma("unroll") for (int d = 0; d < 4; ++d) _Pragma("unroll") for (int r = 0; r < 16; ++r) o[d][r] *= al_l[crow(r, hi)]; } } while (0)
  f32x16 pA0, pA1, pB0, pB1; float mnA, mnB, alA, alB; h16x8 pa0, pa1, pa2, pa3; const int NT = seq / KVBLK;
  constexpr int SE = 0, SO = SDEPTH - 1;
  SLOAD(SE, 0); asm volatile("s_waitcnt vmcnt(0)" ::: "memory"); SWRITE(0, SE); __syncthreads();
  qkt(pA0, pA1, K_lds, qr, r32, hi, th); partialSM(pA0, pA1, m_reg, mnA, alA);
  SLOAD(SO, KVBLK); if constexpr (SDEPTH == 2) { if (2 < NT) SLOAD(SE, 2 * KVBLK); }
  SWAIT(); SWRITE(1, SO); __syncthreads();
  for (int j = 1; j + 1 < NT; j += 2) {
    SBAR(); qkt(pB0, pB1, K_lds + SHM_K, qr, r32, hi, th);
    finishSM(pA0, pA1, alA, l_reg, pa0, pa1, pa2, pa3); SBAR();
    SLOAD(SO, (j + SDEPTH) * KVBLK); SBAR();
    pv_d0(o, vb0, pa0, pa1, pa2, pa3); partialSM(pB0, pB1, m_reg, mnB, alB);
    __syncthreads(); SWAIT(); SWRITE(0, SE);
    RESC(alB); __syncthreads();
    SBAR(); qkt(pA0, pA1, K_lds, qr, r32, hi, th);
    finishSM(pB0, pB1, alB, l_reg, pa0, pa1, pa2, pa3); SBAR();
    if (SDEPTH == 1 || j + 3 < NT) SLOAD(SE, (j + 1 + SDEPTH) * KVBLK); SBAR();
    pv_d0(o, vb0 + (int)SHM_V, pa0, pa1, pa2, pa3); partialSM(pA0, pA1, m_reg, mnA, alA);
    __syncthreads(); SWAIT(); SWRITE(1, SO);
    RESC(alA); __syncthreads();
  }
  SBAR(); qkt(pB0, pB1, K_lds + SHM_K, qr, r32, hi, th);
  finishSM(pA0, pA1, alA, l_reg, pa0, pa1, pa2, pa3); SBAR();
  pv_d0(o, vb0, pa0, pa1, pa2, pa3); partialSM(pB0, pB1, m_reg, mnB, alB);
  __syncthreads(); RESC(alB);
  finishSM(pB0, pB1, alB, l_reg, pa0, pa1, pa2, pa3); SBAR();
  pv_d0(o, vb0 + (int)SHM_V, pa0, pa1, pa2, pa3);
  if (hi == 0) li_l[r32] = l_reg; asm volatile("s_waitcnt lgkmcnt(0)" ::: "memory");
  float rli[16];
#pragma unroll
  for (int r = 0; r < 16; ++r) rli[r] = __builtin_amdgcn_rcpf(li_l[crow(r, hi)]);
  __syncthreads();
  float* X = (float*)lds + qg * 4096;
  if (th == 1) {
#pragma unroll
    for (int r = 0; r < 16; ++r)
#pragma unroll
      for (int d0 = 0; d0 < 4; ++d0) X[(r * 4 + d0) * 64 + lane] = o[d0][r] * rli[r] * (-lam);
  }
  __syncthreads();
  if (th == 0) {
    float gv[4];
#pragma unroll
    for (int d0 = 0; d0 < 4; ++d0) gv[d0] = gsub[d0 * 32 + r32] * oml;
    h16* Ow = Ob + (long)(qg * QBLK) * LDO;
#pragma unroll
    for (int r = 0; r < 16; ++r) {
      float v[4], ss = 0.f;
#pragma unroll
      for (int d0 = 0; d0 < 4; ++d0) { v[d0] = o[d0][r] * rli[r] + X[(r * 4 + d0) * 64 + lane]; ss += v[d0] * v[d0]; }
      ss += __shfl_xor(ss, 1); ss += __shfl_xor(ss, 2); ss += __shfl_xor(ss, 4); ss += __shfl_xor(ss, 8); ss += __shfl_xor(ss, 16);
      const float rs = rsqrtf(ss * (1.f / 128.f) + SUBLN_EPS);
      const int orow = crow(r, hi);
#pragma unroll
      for (int d0 = 0; d0 < 4; ++d0) Ow[(long)orow * LDO + d0 * 32 + r32] = (h16)(v[d0] * rs * gv[d0]);
    }
  }
  __syncthreads();
#undef SLOAD
#undef SWRITE
#undef SWAIT
#undef RESC
}
#undef SBAR
}

#define XB_TMO      128
#define XB_XCNT(j)  (256  + 64 * (j))
#define XB_XSUB(j)  (1280 + 64 * (j))
#define XB_XGEN(j)  (2304 + 64 * (j))
#define XB_TOP      3328
#define XB_TOPGEN   3392
#define XCD_BAR_WORDS 3456
#define XB_SPIN_CAP (1u << 20)
__device__ __forceinline__ unsigned xb_ld(unsigned* p)              { return __hip_atomic_load(p, __ATOMIC_RELAXED, __HIP_MEMORY_SCOPE_AGENT); }
__device__ __forceinline__ unsigned xb_add(unsigned* p, unsigned v) { return __hip_atomic_fetch_add(p, v, __ATOMIC_RELAXED, __HIP_MEMORY_SCOPE_AGENT); }
__device__ __forceinline__ unsigned xb_xcc_id() { return (unsigned)__builtin_amdgcn_s_getreg((3 << 11) | 20) & 0xFu; }
#define XB_SPIN(cond, bar) do { unsigned _sp = 0; while (cond) { __builtin_amdgcn_s_sleep(1); \
    if ((++_sp & 255u) == 0u) { if (xb_ld(&(bar)[XB_TMO])) break; if (_sp > XB_SPIN_CAP) { atomicAdd(&(bar)[XB_TMO], 1u); break; } } } } while (0)
struct XcdBarrier { unsigned* bar; unsigned x; volatile LAS unsigned* st; };
__device__ __forceinline__ XcdBarrier xcd_barrier_post(unsigned* bar, volatile LAS unsigned* st, int tid) {
    XcdBarrier b; b.bar = bar; b.x = xb_xcc_id(); b.st = st;
    if (tid == 0) (void)xb_add(&bar[XB_XCNT(b.x)], 1u);
    return b;
}
__device__ __forceinline__ void xcd_barrier_complete(unsigned* bar, unsigned x, unsigned& nloc, unsigned& nx) {
    const unsigned G = gridDim.x * gridDim.y * gridDim.z;
    unsigned sum, cnt, mine, sp = 0u;
    for (;;) {
        sum = 0u; cnt = 0u; mine = 0u;
#pragma unroll
        for (unsigned j = 0; j < 16; ++j) { const unsigned c = xb_ld(&bar[XB_XCNT(j)]); sum += c; cnt += (c > 0u) ? 1u : 0u; mine = (j == x) ? c : mine; }
        if (sum == G) break;
        __builtin_amdgcn_s_sleep(1);
        if ((++sp & 255u) == 0u) { if (xb_ld(&bar[XB_TMO])) break; if (sp > XB_SPIN_CAP) { atomicAdd(&bar[XB_TMO], 1u); break; } }
    }
    nloc = mine > 0u ? mine : 1u; nx = cnt > 0u ? cnt : 1u;
}
__device__ __forceinline__ void xcd_barrier(const XcdBarrier& b, int tid) {
    asm volatile("s_waitcnt vmcnt(0)" ::: "memory");
    __syncthreads();
    if (tid == 0) {
        unsigned* bar = b.bar;
        __builtin_amdgcn_s_waitcnt(0);
        unsigned nloc = b.st[0], nx = b.st[1];
        if (nloc == 0u) { xcd_barrier_complete(bar, b.x, nloc, nx); b.st[0] = nloc; b.st[1] = nx; }
        const unsigned old = xb_add(&bar[XB_XSUB(b.x)], 1u);
        const unsigned gen = old / nloc;
        if (old + 1u == (gen + 1u) * nloc) {
            __builtin_amdgcn_fence(__ATOMIC_RELEASE, "agent");
            asm volatile("s_waitcnt vmcnt(0)" ::: "memory");
            const unsigned og = xb_add(&bar[XB_TOP], 1u);
            const unsigned tg = og / nx;
            if (og + 1u == (tg + 1u) * nx) xb_add(&bar[XB_TOPGEN], 1u);
            else XB_SPIN(xb_ld(&bar[XB_TOPGEN]) == tg, bar);
            __builtin_amdgcn_fence(__ATOMIC_ACQUIRE, "agent");
            xb_add(&bar[XB_XGEN(b.x)], 1u);
            asm volatile("s_waitcnt vmcnt(0)" ::: "memory");
        } else {
            XB_SPIN(xb_ld(&bar[XB_XGEN(b.x)]) == gen, bar);
            __builtin_amdgcn_fence(__ATOMIC_ACQUIRE, "agent");
            asm volatile("s_waitcnt vmcnt(0)" ::: "memory");
        }
    }
    __syncthreads();
}

struct Args { const float* in[24]; float* out; unsigned char* ws; int s_lo, s_hi; };
enum { I_XP = 0, I_XS, I_CK, I_CV, I_C, I_CCTX, I_WADA, I_BADA, I_WF, I_WQKV, I_LQ1, I_LK1, I_LQ2, I_LK2, I_SUBG, I_WO, I_WUP, I_CONVW, I_CONVB, I_WDN, I_LN1G, I_LN1B, I_LN2G, I_LN2B };

constexpr int PTAB_OFF = LDSCTL_OFF + 512;
struct PArgs { const LAS unsigned long long* tab; float* out; unsigned char* ws;
    __device__ __forceinline__ const float* in(int i) const { const unsigned long long v = tab[i];
        const unsigned lo = __builtin_amdgcn_readfirstlane((unsigned)v), hi = __builtin_amdgcn_readfirstlane((unsigned)(v >> 32)); return (const float*)(const GAS float*)(((unsigned long long)hi << 32) | lo); } };
struct Frame {
    LAS unsigned char* lds; char* ldsg;
    int tid, lane, wave, vcu, G;
};
__device__ __forceinline__ float wave_sum(float v) {
#pragma unroll
    for (int o = 1; o < 64; o <<= 1) v += __shfl_xor(v, o);
    return v;
}
__device__ __forceinline__ void transpose_item(const float* W, int K, int N, h16* WT, LAS float* scr, int item, int lane, bool upperm = false) {
    const int nblk = N / 32, kb = item / nblk, nb = item % nblk, k0 = 64 * kb, n0 = 32 * nb;
    int d0 = n0; if (upperm) { const int part = n0 >= DFF, nn = n0 - part * DFF; d0 = (nn >> 7) * 256 + part * 128 + (nn & 127); }
#pragma unroll 8
    for (int i = 0; i < 32; ++i) { const int kk = 2 * i + (lane >> 5); scr[kk * 33 + (lane & 31)] = W[(size_t)(k0 + kk) * N + n0 + (lane & 31)]; }
    asm volatile("s_waitcnt lgkmcnt(0)" ::: "memory");
    const int c = lane & 7;
#pragma unroll
    for (int j = 0; j < 4; ++j) { const int n = (lane >> 3) + 8 * j; const LAS float* s = scr + (8 * c) * 33 + n;
        u32x4 o; o.x = pkh(s[0 * 33], s[1 * 33]); o.y = pkh(s[2 * 33], s[3 * 33]); o.z = pkh(s[4 * 33], s[5 * 33]); o.w = pkh(s[6 * 33], s[7 * 33]);
        *(u32x4*)(WT + (size_t)(d0 + n) * K + k0 + 8 * c) = o; }
    asm volatile("s_waitcnt lgkmcnt(0)" ::: "memory");
}
__device__ __forceinline__ float silu_f(float x) { return x / (1.f + __expf(-x)); }

__device__ __forceinline__ void step_prep(const Frame& F, const PArgs& a, int L, bool first) {
    unsigned char* ws = a.ws;
    const int gw = F.vcu * 8 + F.wave, NGW = F.G * 8;
    if (first) {
        LAS float* S = (LAS float*)F.lds;
        LAS float* red = (LAS float*)(F.lds + 20480);
        if (F.vcu < 384) {
            for (int i = F.tid; i < 5 * 1024; i += 512) { const int cd = i >> 10, k = i & 1023; const float x = cd == 0 ? a.in(I_CCTX)[k] : a.in(I_C)[(cd - 1) * 1024 + k]; S[i] = silu_f(x); }
            __syncthreads();
            for (int it = F.vcu; it < 384; it += F.G) {
                const int Ly = it / 96, ch = it % 96; const int cq = F.lane & 15, kg = F.lane >> 4;
                const float* Wp = a.in(I_WADA) + (size_t)Ly * 1024 * 6144 + ch * 64 + cq * 4;
                f32x4 acc[5];
#pragma unroll
                for (int c = 0; c < 5; ++c) acc[c] = (f32x4){0.f, 0.f, 0.f, 0.f};
#pragma unroll 4
                for (int i = 0; i < 32; ++i) { const int k = F.wave * 128 + 4 * i + kg; const f32x4 w = *(const f32x4*)(Wp + (size_t)k * 6144);
#pragma unroll
                    for (int c = 0; c < 5; ++c) acc[c] += w * S[c * 1024 + k]; }
#pragma unroll
                for (int c = 0; c < 5; ++c)
#pragma unroll
                    for (int e = 0; e < 4; ++e) { float v = acc[c][e]; v += __shfl_xor(v, 16); v += __shfl_xor(v, 32); acc[c][e] = v; }
                if (kg == 0) {
#pragma unroll
                    for (int c = 0; c < 5; ++c)
#pragma unroll
                        for (int e = 0; e < 4; ++e) red[(F.wave * 5 + c) * 64 + cq * 4 + e] = acc[c][e]; }
                __syncthreads();
                if (F.tid < 320) { const int c = F.tid >> 6, col = F.tid & 63; float s = a.in(I_BADA)[Ly * 6144 + ch * 64 + col];
#pragma unroll
                    for (int w = 0; w < 8; ++w) s += red[(w * 5 + c) * 64 + col];
                    ((float*)(ws + WS_ADA))[(Ly * 5 + c) * 6144 + ch * 64 + col] = s; }
                __syncthreads();
            }
        }
        if (F.vcu == 0) {
            float* rope = (float*)(ws + WS_ROPE);
            for (int i = F.tid; i < 1024; i += 512) { const int pos = i >> 4, f = i & 15; const float inv = exp2f(-(float)f * (13.287712379549449f / 16.f)); const float ang = (float)pos * inv;
                rope[i] = cosf(ang); rope[1024 + i] = sinf(ang); }
            if (F.tid < 2) { const int j = F.tid; float s1 = 0.f, s2 = 0.f;
                for (int d = 0; d < 64; ++d) { s1 += a.in(I_LQ1)[j * 64 + d] * a.in(I_LK1)[j * 64 + d]; s2 += a.in(I_LQ2)[j * 64 + d] * a.in(I_LK2)[j * 64 + d]; }
                const float li = 0.8f - 0.6f * expf(-0.3f * (float)(2 * j + 1));
                rope[2048 + j] = expf(s1) - expf(s2) + li; rope[2050 + j] = 1.f - li; }
        }
        {
            const int gt = F.vcu * 512 + F.tid, NGT = F.G * 512;
            h16* d256 = (h16*)(ws + WS_D256); h16* d2k = (h16*)(ws + WS_D2048);
            for (int it = gt; it < 3 * 256 * 32; it += NGT) { const int mat = it / (256 * 32), j = (it / 32) % 256, k0 = (it % 32) * 8; float v[8];
#pragma unroll
                for (int e = 0; e < 8; ++e) { const int m = (j * (k0 + e)) & 255; const float x = (float)m * (1.f / 128.f); v[e] = (mat == 0 ? cospif(x) : (mat == 1 ? -sinpif(x) : sinpif(x))) * 0.0625f; }
                u32x4 o = {pkh(v[0], v[1]), pkh(v[2], v[3]), pkh(v[4], v[5]), pkh(v[6], v[7])}; *(u32x4*)(d256 + (size_t)it * 8) = o; }
            for (int it = gt; it < 2 * 2048 * 256; it += NGT) { const int mat = it / (2048 * 256), j = (it / 256) % 2048, k0 = (it % 256) * 8; float v[8];
#pragma unroll
                for (int e = 0; e < 8; ++e) { const int m = (j * (k0 + e)) & 2047; const float x = (float)m * (1.f / 1024.f); v[e] = (mat == 0 ? cospif(x) : sinpif(x)) * 0.022097086912079608f; }
                u32x4 o = {pkh(v[0], v[1]), pkh(v[2], v[3]), pkh(v[4], v[5]), pkh(v[6], v[7])}; *(u32x4*)(d2k + (size_t)it * 8) = o; }
        }
        __syncthreads();
    }
    LAS float* scr = (LAS float*)(F.lds + F.wave * 16384);
    const bool att = (L & 1) != 0; const int j = L >> 1;
    const int I_UP = (1024 / 64) * (DFF2 / 32), I_DN = (DFF / 64) * (1024 / 32), I_QKV = att ? (1024 / 64) * (3072 / 32) : 0, I_O = att ? 512 : 0, I_F = first ? 1024 : 0, I_CR = att ? 2 * NBL * PAST : 0;
    const int NIT = I_UP + I_DN + I_QKV + I_O + I_F + I_CR;
    for (int it = gw; it < NIT; it += NGW) {
        int r = it;
        if (r < I_UP) { transpose_item(a.in(I_WUP) + (size_t)L * 1024 * DFF2, 1024, DFF2, (h16*)(ws + WS_WUP), scr, r, F.lane, true); continue; } r -= I_UP;
        if (r < I_DN) { transpose_item(a.in(I_WDN) + (size_t)L * DFF * 1024, DFF, 1024, (h16*)(ws + WS_WDN), scr, r, F.lane); continue; } r -= I_DN;
        if (r < I_QKV) { transpose_item(a.in(I_WQKV) + (size_t)j * 1024 * 3072, 1024, 3072, (h16*)(ws + WS_WQKV), scr, r, F.lane); continue; } r -= I_QKV;
        if (r < I_O) { transpose_item(a.in(I_WO) + (size_t)j * 1024 * 1024, 1024, 1024, (h16*)(ws + WS_WO), scr, r, F.lane); continue; } r -= I_O;
        if (r < I_F) { const int ly = r >> 9; transpose_item(a.in(I_WF) + (size_t)ly * 1024 * 1024, 1024, 1024, (h16*)(ws + WS_WFT) + (size_t)ly * 1024 * 1024, scr, r & 511, F.lane); continue; } r -= I_F;
        { const int kv = r / (NBL * PAST), rr = r % (NBL * PAST), b = rr / PAST, p = rr % PAST;
          const float* src = a.in(kv ? I_CV : I_CK) + ((size_t)(b * 2 + j) * PAST + p) * DM; h16* dst = (h16*)(ws + (kv ? WS_V : WS_K)) + ((size_t)NCTX + (size_t)b * KVL + SEQL + p) * DM;
#pragma unroll
          for (int q = 0; q < 4; ++q) { const f32x4 v = *(const f32x4*)(src + q * 256 + F.lane * 4); u32x2 o = {pkh(v[0], v[1]), pkh(v[2], v[3])}; *(u32x2*)(dst + q * 256 + F.lane * 4) = o; } }
    }
}

__device__ __forceinline__ f32x8 ld8f(const float* p) { return *(const f32x8*)p; }
__device__ __forceinline__ f32x8 ld8h(const h16* p) { const h16x8 v = *(const h16x8*)p; return __builtin_convertvector(v, f32x8); }
__device__ __forceinline__ void st8h(h16* p, const f32x8 v) { u32x4 o = {pkh(v[0], v[1]), pkh(v[2], v[3]), pkh(v[4], v[5]), pkh(v[6], v[7])}; *(u32x4*)p = o; }
__device__ __forceinline__ float sum8(const f32x8 v) { return ((v[0] + v[1]) + (v[2] + v[3])) + ((v[4] + v[5]) + (v[6] + v[7])); }
__device__ __forceinline__ void step_ln(const Frame& F, const PArgs& a, int mode, int L, bool two_u) {
    unsigned char* ws = a.ws;
    const int gw = F.vcu * 8 + F.wave, NGW = F.G * 8;
    const float* ada = (const float*)(ws + WS_ADA);
    const h16* U0 = (const h16*)(ws + (mode == 2 ? WS_UD : WS_U0)); const h16* U1 = (const h16*)(ws + WS_U1); h16* H = (h16*)(ws + WS_H); h16* XH = (h16*)(ws + WS_XH);
    const bool from_in = (mode == 0) || (mode == 1 && L == 0);
    const bool last = (mode == 2 && L == DEPTH - 1);
    const bool has_h = !last;
    const int Lh = (mode == 2) ? L + 1 : L;
    const int jsh = (mode == 1) ? 3 : 0, jsc = jsh + 1, jg = (mode == 1) ? 2 : 5;
    const float* lng = a.in(mode == 1 ? I_LN1G : I_LN2G) + L * DM; const float* lnb = a.in(mode == 1 ? I_LN1B : I_LN2B) + L * DM;
    for (int chunk = gw; chunk < NTOK / 8; chunk += NGW) {
        const int row0 = chunk * 8; const int cond = row0 < NCTX ? 0 : 1 + ((row0 - NCTX) >> 11);
        f32x8 gate[2], vg[2], vb[2], vsc[2], vsh[2];
#pragma unroll
        for (int q = 0; q < 2; ++q) { const int c = q * 512 + F.lane * 8;
            if (mode != 0) { gate[q] = ld8f(ada + (size_t)(L * 5 + cond) * 6144 + jg * 1024 + c); vg[q] = ld8f(lng + c); vb[q] = ld8f(lnb + c); }
            if (has_h) { vsc[q] = ld8f(ada + (size_t)(Lh * 5 + cond) * 6144 + jsc * 1024 + c) + 1.f; vsh[q] = ld8f(ada + (size_t)(Lh * 5 + cond) * 6144 + jsh * 1024 + c); } }
#pragma unroll 2
        for (int rr = 0; rr < 8; ++rr) {
            const int row = row0 + rr; const size_t ro = (size_t)row * DM + F.lane * 8;
            f32x8 v[2];
            if (from_in) { const float* xr = (row < NCTX ? a.in(I_XP) : a.in(I_XS) - (size_t)NCTX * DM) + ro; v[0] = ld8f(xr); v[1] = ld8f(xr + 512); }
            else { v[0] = ld8h(XH + ro); v[1] = ld8h(XH + ro + 512); }
            if (mode != 0) {
                float s = 0.f;
#pragma unroll
                for (int q = 0; q < 2; ++q) { f32x8 uf = ld8h(U0 + ro + q * 512); if (two_u) uf += ld8h(U1 + ro + q * 512);
                    v[q] = v[q] * DN_ALPHA + gate[q] * uf; s += sum8(v[q]); }
                const float mean = wave_sum(s) * (1.f / DM); float s2 = 0.f;
#pragma unroll
                for (int q = 0; q < 2; ++q) { v[q] = v[q] - mean; s2 += sum8(v[q] * v[q]); }
                const float rstd = rsqrtf(wave_sum(s2) * (1.f / DM) + LN_EPS);
#pragma unroll
                for (int q = 0; q < 2; ++q) { v[q] = v[q] * rstd * vg[q] + vb[q];
                    if (last) { *(f32x8*)(a.out + ro + q * 512) = v[q]; } else st8h(XH + ro + q * 512, v[q]); }
            }
            if (has_h) {
                const float mean = wave_sum(sum8(v[0]) + sum8(v[1])) * (1.f / DM); float s2 = 0.f;
#pragma unroll
                for (int q = 0; q < 2; ++q) { v[q] = v[q] - mean; s2 += sum8(v[q] * v[q]); }
                const float rstd = rsqrtf(wave_sum(s2) * (1.f / DM) + LN_EPS);
#pragma unroll
                for (int q = 0; q < 2; ++q) st8h(H + ro + q * 512, v[q] * rstd * vsc[q] + vsh[q]);
            }
        }
    }
}

__device__ __forceinline__ void step_convgate(const Frame& F, const PArgs& a, int L) {
    unsigned char* ws = a.ws;
    const int gw = F.vcu * 8 + F.wave, NGW = F.G * 8;
    const h16* UU = (const h16*)(ws + WS_ARENA); h16* ACT = (h16*)(ws + WS_ACT);
    const float* cw = a.in(I_CONVW) + (size_t)L * 3 * DFF2; const float* cb = a.in(I_CONVB) + (size_t)L * DFF2;
    const int rg = F.lane >> 4, cl = F.lane & 15;
    for (int it = gw; it < 512 * 22; it += NGW) {
        const int rb = it / 22, cg = it % 22; const int col = cg * 128 + cl * 8;
        const int r0 = rb * 32 + rg * 8;
        const int seqlen_m1 = r0 < NCTX ? SEQC - 1 : SEQL - 1; const int t0 = (r0 < NCTX ? r0 : r0 - NCTX) & seqlen_m1;
        const bool zp = (t0 == 0), zn = (t0 + 8 > seqlen_m1);
        h16x8 u[2][10];
        const h16x8 zero = {0, 0, 0, 0, 0, 0, 0, 0};
#pragma unroll
        for (int p = 0; p < 2; ++p) {
            const h16* b = UU + (size_t)r0 * DFF2 + p * DFF + col;
            u[p][0] = zp ? zero : *(const h16x8*)(b - DFF2);
#pragma unroll
            for (int i = 0; i < 8; ++i) u[p][1 + i] = *(const h16x8*)(b + (size_t)i * DFF2);
            u[p][9] = zn ? zero : *(const h16x8*)(b + (size_t)8 * DFF2);
        }
        float w[2][3][8], bb[2][8];
#pragma unroll
        for (int p = 0; p < 2; ++p) {
#pragma unroll
            for (int d = 0; d < 3; ++d) { const f32x8 x = ld8f(cw + d * DFF2 + p * DFF + col);
#pragma unroll
                for (int e = 0; e < 8; ++e) w[p][d][e] = x[e]; }
            const f32x8 y = ld8f(cb + p * DFF + col);
#pragma unroll
            for (int e = 0; e < 8; ++e) bb[p][e] = y[e]; }
#pragma unroll
        for (int i = 0; i < 8; ++i) {
            float av[8];
#pragma unroll
            for (int e = 0; e < 8; ++e) {
                const float x = w[0][0][e] * (float)u[0][i][e] + w[0][1][e] * (float)u[0][i + 1][e] + w[0][2][e] * (float)u[0][i + 2][e] + bb[0][e];
                const float g = w[1][0][e] * (float)u[1][i][e] + w[1][1][e] * (float)u[1][i + 1][e] + w[1][2][e] * (float)u[1][i + 2][e] + bb[1][e];
                av[e] = x * __builtin_amdgcn_rcpf(1.f + __expf(-x)) * g; }
            u32x4 o = {pkh(av[0], av[1]), pkh(av[2], av[3]), pkh(av[4], av[5]), pkh(av[6], av[7])};
            *(u32x4*)(ACT + (size_t)(r0 + i) * DFF + col) = o;
        }
    }
}

__device__ __forceinline__ void step_attn(const Frame& F, const PArgs& a, int L) {
    unsigned char* ws = a.ws; const int j = L >> 1;
    const h16* Q = (const h16*)(ws + WS_Q); const h16* K = (const h16*)(ws + WS_K); const h16* V = (const h16*)(ws + WS_V); h16* O = (h16*)(ws + WS_O);
    const float* lamp = (const float*)(ws + WS_ROPE) + 2048; const float lam = lamp[j], oml = lamp[2 + j];
    const float* gsub = a.in(I_SUBG) + j * 128;
    for (int it = F.vcu; it < 1024; it += F.G) {
        int kind, id;
        if (F.G == 256) { kind = (it >> 8) & 1; id = ((it >> 9) << 8) + (it & 255); }
        else { kind = it >= 512; id = it & 511; }
        size_t qrow, krow; int h, seq;
        if (kind == 0) { const int bh = id >> 4, qb = id & 15, b = bh >> 3; h = bh & 7; qrow = (size_t)NCTX + (size_t)b * SEQL + qb * 128; krow = (size_t)NCTX + (size_t)b * KVL; seq = KVL; }
        else { const int bh = id >> 1, qb = id & 1, b = bh >> 3; h = bh & 7; qrow = (size_t)b * SEQC + qb * 128; krow = (size_t)b * SEQC; seq = SEQC; }
        attn::unit(F.tid, Q + qrow * DM + h * 128, K + krow * DM + h * 128, V + krow * DM + h * 128, O + qrow * DM + h * 128, seq, F.ldsg, lam, oml, gsub);
    }
}

enum { K_PREP0 = 0, K_GEMM, K_QKV, K_LN, K_UP, K_ATT };
enum { GV_WP = 0, GV_FA, GV_FBL, GV_FBC, GV_O, GV_UP, GV_DN };
constexpr int NSTEPS = 3 + 7 * DEPTH;

__global__ void __launch_bounds__(512, 2) dit_fwd(Args args) {
    extern __shared__ __attribute__((aligned(16))) unsigned char lds_raw[];
    const int wave_s = __builtin_amdgcn_readfirstlane((int)threadIdx.x >> 6);
    unsigned char* ws = args.ws;
    volatile LAS unsigned* MISC = (volatile LAS unsigned*)((LAS unsigned char*)lds_raw + MISC_OFF);
    for (int u = threadIdx.x; u < (LDS_BYTES - LDSCTL_OFF) / 4; u += 512) ((LAS unsigned*)((LAS unsigned char*)lds_raw + LDSCTL_OFF))[u] = 0u;
    __syncthreads();
    if (threadIdx.x == 0) {
#pragma unroll
        for (int i = 0; i < 24; ++i) ((LAS unsigned long long*)((LAS unsigned char*)lds_raw + PTAB_OFF))[i] = (unsigned long long)args.in[i]; }
    __syncthreads();
    PArgs pa; pa.tab = (const LAS unsigned long long*)((LAS unsigned char*)lds_raw + PTAB_OFF); pa.out = args.out; pa.ws = args.ws;
#if !MK_PER_STEP_LAUNCH
    XcdBarrier bar = xcd_barrier_post((unsigned*)(ws + WS_CTL) + CW_BAR, MISC + 8, (int)threadIdx.x);
#endif
    for (int ss = 2 * args.s_lo; ss < 2 * args.s_hi; ++ss) {
        const int s = ss >> 1, rep = ss & 1;
#define MK_FRAME() Frame F; { int l_; asm volatile("v_mbcnt_lo_u32_b32 %0, -1, 0\n\tv_mbcnt_hi_u32_b32 %0, -1, %0" : "=v"(l_)); F.tid = wave_s * 64 + l_; } \
        F.lds = (LAS unsigned char*)lds_raw; F.ldsg = (char*)lds_raw; F.lane = F.tid & 63; F.wave = wave_s; \
        F.G = gridDim.x; { const int bx = blockIdx.x; F.vcu = (F.G % 8 == 0) ? (bx % 8) * (F.G / 8) + bx / 8 : bx; }
        int kind, L = 0, var = 0, mode = 0; bool sync_after = true, two_u = false;
        if (s == 0) kind = K_PREP0;
        else if (s == 1) { kind = K_GEMM; var = GV_WP; sync_after = false; }
        else if (s == 2) { kind = K_LN; mode = 0; }
        else { const int q = s - 3; L = q / 7; const int jj = q % 7; const bool att = (L & 1) != 0;
            switch (jj) {
                case 0: if (att) kind = K_QKV; else { kind = K_GEMM; var = GV_FA; } break;
                case 1: if (att) kind = K_ATT; else { kind = K_GEMM; var = GV_FBL; sync_after = false; } break;
                case 2: kind = K_GEMM; var = att ? GV_O : GV_FBC; break;
                case 3: kind = K_LN; mode = 1; two_u = !att; break;
                case 4: kind = K_UP; break;
                case 5: kind = K_GEMM; var = GV_DN; break;
                default: kind = K_LN; mode = 2; break;
            }
        }
        { const int bit = kind == K_GEMM ? 1 : kind == K_QKV ? 2 : kind == K_ATT ? 4 : kind == K_PREP0 ? 8 : kind == K_UP ? 32 : (kind == K_LN && mode == 0) ? 64 : 0; if (rep == 0 && !(PROBE_REPEAT & bit)) continue; }
        if (kind == K_PREP0) { MK_FRAME(); step_prep(F, pa, 0, true); }
        else if (kind == K_GEMM) {
            MK_FRAME();
            pg8::GSched S; S.G = F.G; S.c = (int)blockIdx.x; S.n0 = 1; S.n1 = 1; S.upmode = 0;
            for (int i = 0; i < 3; ++i) { S.as[i] = 0; S.bs[i] = 0; S.os[i] = 0; }
            int K = 1024; h16* halo = nullptr;
            if (var == GV_WP) { S.nM = 4; S.nN = 1; S.n0 = 4; S.n1 = 2; S.A = (const char*)(ws + WS_WFT); S.B = (const char*)(ws + WS_D256); S.O = (h16*)(ws + WS_WPT);
                S.lda = 1024; S.ldb = 256; S.ldc = 1024; K = 256;
                S.as[0] = 256 * 2; S.bs[0] = 0; S.os[0] = 256;
                S.as[1] = 0; S.bs[1] = 256 * 256 * 2; S.os[1] = 1024 * 1024;
                S.as[2] = 1024 * 1024 * 2; S.bs[2] = 0; S.os[2] = 2048 * 1024;
                S.total = 4 * 1 * 4 * 2 * 2; }
            else if (var == GV_FA) { S.nM = 8; S.nN = 64; S.A = (const char*)(ws + WS_WPT) + (size_t)(L >> 1) * 2048 * 1024 * 2; S.B = (const char*)(ws + WS_H); S.O = (h16*)(ws + WS_ARENA);
                S.lda = 1024; S.ldb = 1024; S.ldc = NTOK; K = 1024; S.total = 512; }
            else if (var == GV_FBL) { S.nM = 8; S.nN = 4; S.n0 = 4; S.n1 = 2; S.A = (const char*)(ws + WS_D2048); S.B = (const char*)(ws + WS_ARENA) + (size_t)NCTX * 2; S.O = (h16*)(ws + WS_U0) + (size_t)NCTX * DM;
                S.lda = 2048; S.ldb = NTOK; S.ldc = DM; K = 2048;
                S.as[0] = 0; S.bs[0] = 2048 * 2; S.os[0] = 2048 * DM;
                S.as[1] = 2048L * 2048 * 2; S.bs[1] = 1024L * NTOK * 2; S.os[1] = (long)NTOK * DM;
                S.total = 32 * 8; }
            else if (var == GV_FBC) { S.nM = 1; S.nN = 4; S.n0 = 32; S.n1 = 2; S.A = (const char*)(ws + WS_D256); S.B = (const char*)(ws + WS_ARENA); S.O = (h16*)(ws + WS_U0);
                S.lda = 256; S.ldb = NTOK; S.ldc = DM; K = 256;
                S.as[0] = 0; S.bs[0] = 256 * 2; S.os[0] = 256 * DM;
                S.as[1] = 2 * 256 * 256 * 2; S.bs[1] = 1024L * NTOK * 2; S.os[1] = (long)NTOK * DM;
                S.total = 4 * 64; }
            else if (var == GV_O) { S.nM = 64; S.nN = 4; S.A = (const char*)(ws + WS_O); S.B = (const char*)(ws + WS_WO); S.O = (h16*)(ws + WS_U0); S.lda = 1024; S.ldb = 1024; S.ldc = DM; K = 1024; S.total = 256; }
            else { S.nM = 64; S.nN = 4; S.A = (const char*)(ws + WS_ACT); S.B = (const char*)(ws + WS_WDN); S.O = (h16*)(ws + WS_UD); S.lda = DFF; S.ldb = DFF; S.ldc = DM; K = DFF; S.total = 256; }
            S.nwg = S.nM * S.nN;
            pg8::EpiStore16 E{S.ldc, halo};
            pg8::gemm_phase<pg8::EpiStore16, pg8::GSched>(F.lds, F.tid, K, S.lda, S.ldb, S, E);
        }
        else if (kind == K_QKV) {
            MK_FRAME();
            pg8::GSched S; S.G = F.G; S.c = (int)blockIdx.x; S.n0 = 1; S.n1 = 1; S.upmode = 0;
            for (int i = 0; i < 3; ++i) { S.as[i] = 0; S.bs[i] = 0; S.os[i] = 0; }
            S.nM = 64; S.nN = 12; S.nwg = 768; S.total = 768; S.A = (const char*)(ws + WS_H); S.B = (const char*)(ws + WS_WQKV); S.O = nullptr; S.lda = 1024; S.ldb = 1024; S.ldc = DM;
            pg8::EpiQKV E{(h16*)(ws + WS_Q), (h16*)(ws + WS_K), (h16*)(ws + WS_V), args.out + 16777216, args.out + 33554432, (const float*)(ws + WS_ROPE), L >> 1};
            pg8::gemm_phase<pg8::EpiQKV, pg8::GSched>(F.lds, F.tid, 1024, 1024, 1024, S, E);
        }
        else if (kind == K_LN) {
            MK_FRAME();
            step_ln(F, pa, mode, L, two_u);
            if (mode == 2 && L + 1 < DEPTH) step_prep(F, pa, L + 1, false);
        }
        else if (kind == K_UP) {
            MK_FRAME();
            pg8::GSched S; S.G = F.G; S.c = (int)blockIdx.x; S.n0 = 1; S.n1 = 1; S.upmode = 1;
            for (int i = 0; i < 3; ++i) { S.as[i] = 0; S.bs[i] = 0; S.os[i] = 0; }
            S.nM = 68; S.nN = 22; S.nwg = 68 * 22; S.total = 68 * 22; S.A = (const char*)(ws + WS_H); S.B = (const char*)(ws + WS_WUP); S.O = nullptr; S.lda = 1024; S.ldb = 1024; S.ldc = DFF;
            pg8::EpiConvGate E{(h16*)(ws + WS_ACT), pa.in(I_CONVW) + (size_t)L * 3 * DFF2, pa.in(I_CONVB) + (size_t)L * DFF2};
            pg8::gemm_phase<pg8::EpiConvGate, pg8::GSched>(F.lds, F.tid, 1024, 1024, 1024, S, E);
        }
        else { MK_FRAME(); step_attn(F, pa, L); }
#if !MK_PER_STEP_LAUNCH
        if (rep == 1 && sync_after && s + 1 < args.s_hi) { int l2_; asm volatile("v_mbcnt_lo_u32_b32 %0, -1, 0\n\tv_mbcnt_hi_u32_b32 %0, -1, %0" : "=v"(l2_)); const int tid2 = wave_s * 64 + l2_;
            xcd_barrier(bar, tid2); if (PROBE_REPEAT & 16) xcd_barrier(bar, tid2); }
        else __syncthreads();
#else
        (void)sync_after; __syncthreads();
#endif
    }
}

extern "C" void kernel_launch(void* const* d_in, const int* in_sizes, int n_in, void* d_out, int out_size, void* d_ws, size_t ws_size, hipStream_t stream) {
    static int grid = 0;
    if (grid == 0) {
        if (n_in != 24 || out_size != 50331648 || ws_size < WS_END) { fprintf(stderr, "kernel_launch: unexpected shapes: n_in %d out %d ws %zu (need %zu)\n", n_in, out_size, ws_size, (size_t)WS_END); grid = -1; return; }
        int dev = 0, cus = 0, per_cu = 0;
        if (hipGetDevice(&dev) != hipSuccess || hipDeviceGetAttribute(&cus, hipDeviceAttributeMultiprocessorCount, dev) != hipSuccess) { grid = -1; return; }
        if (hipFuncSetAttribute((const void*)dit_fwd, hipFuncAttributeMaxDynamicSharedMemorySize, LDS_BYTES) != hipSuccess) { fprintf(stderr, "kernel_launch: hipFuncSetAttribute failed\n"); grid = -1; return; }
        if (hipOccupancyMaxActiveBlocksPerMultiprocessor(&per_cu, (const void*)dit_fwd, 512, LDS_BYTES) != hipSuccess || per_cu < 1) { fprintf(stderr, "kernel_launch: occupancy query says %d\n", per_cu); per_cu = 1; }
        (void)hipGetLastError();
        grid = cus * (per_cu < 1 ? per_cu : 1);
    }
    if (grid < 0) return;
    (void)hipMemsetAsync((char*)d_ws + WS_CTL, 0, CTL_ZERO_BYTES, stream);
    Args a{};
    for (int i = 0; i < 24; ++i) a.in[i] = (const float*)d_in[i];
    a.out = (float*)d_out; a.ws = (unsigned char*)d_ws;
#if MK_PER_STEP_LAUNCH
    for (int s = 0; s < NSTEPS; ++s) { a.s_lo = s; a.s_hi = s + 1; hipLaunchKernelGGL(dit_fwd, dim3(grid), dim3(512), LDS_BYTES, stream, a); }
#else
    a.s_lo = 0; a.s_hi = NSTEPS;
    { void* kargs[] = {&a};
      if (hipLaunchCooperativeKernel((const void*)dit_fwd, dim3(grid), dim3(512), kargs, LDS_BYTES, stream) != hipSuccess) {
          (void)hipGetLastError(); hipLaunchKernelGGL(dit_fwd, dim3(grid), dim3(512), LDS_BYTES, stream, a); } }
#endif
    const hipError_t le = hipPeekAtLastError();
    if (le != hipSuccess) fprintf(stderr, "kernel_launch: launch failed: %s\n", hipGetErrorName(le));
}
```
